# Optimizing an MI355X kernel written in HIP

```python
import jax
import jax.numpy as jnp
from jax import lax
import numpy as np

D_MODEL = 2048
BATCH = 4
SEQ = 4096
DEPTH = 2

GRID_W = 64
CTX_LEN = 256
D_FF = 5632
N_MOD = 9
EPS = 1e-6
ROPE_BASE = 10000.0
BLOCK = 128

CONV_WIDTH = 1024
CONV_K = 3

MLA_HEADS = 8
MLA_Q_LORA = 512
MLA_KV_LORA = 256
MLA_NOPE = 128
MLA_ROPE = 64
MLA_V = 128
MLA_SCALE = (MLA_NOPE + MLA_ROPE) ** -0.5

GQA_HEADS = 8
GQA_KV_HEADS = 2
GQA_GROUP = GQA_HEADS // GQA_KV_HEADS
GQA_HEAD_DIM = 128
GQA_SCALE = GQA_HEAD_DIM ** -0.5
WINDOW = 128

N_BRANCH = 3
COLS_CONV = 3 * CONV_WIDTH
COLS_MLA = MLA_Q_LORA + MLA_KV_LORA + MLA_ROPE
COLS_GQA = (GQA_HEADS + 2 * GQA_KV_HEADS) * GQA_HEAD_DIM
COLS_GATE = N_BRANCH * D_MODEL
IN_COLS = COLS_CONV + COLS_MLA + COLS_GQA + COLS_GATE
IN_SPLITS = [COLS_CONV, COLS_CONV + COLS_MLA, COLS_CONV + COLS_MLA + COLS_GQA]

kernel_name = "hybrid_dit_conv_mla_swa_macaron"


def rmsnorm(x, g):
    xf = x.astype(jnp.float32)
    y = xf * lax.rsqrt(jnp.mean(xf * xf, axis=-1, keepdims=True) + EPS)
    return (y * g.astype(jnp.float32)).astype(x.dtype)


def modulate(x, shift, scale):
    return x * (1 + scale) + shift


def swiglu(x, w_gu, w_down):
    g, u = jnp.split(x @ w_gu, 2, axis=-1)
    return (jax.nn.silu(g) * u) @ w_down


def rope_1d(x, pos, dim):
    inv = ROPE_BASE ** (-jnp.arange(0, dim, 2, dtype=jnp.float32) / dim)
    ang = pos.astype(jnp.float32)[:, None] * inv[None, :]
    cos = jnp.cos(ang)[:, None, :].astype(x.dtype)
    sin = jnp.sin(ang)[:, None, :].astype(x.dtype)
    x1, x2 = jnp.split(x, 2, axis=-1)
    return jnp.concatenate([x1 * cos - x2 * sin, x1 * sin + x2 * cos], axis=-1)


def rope_2d(x, row, col):
    half = x.shape[-1] // 2
    return jnp.concatenate([rope_1d(x[..., :half], row, half),
                            rope_1d(x[..., half:], col, half)], axis=-1)


def short_conv(u, w):
    s = u.shape[1]
    half = CONV_K // 2
    up = jnp.pad(u, ((0, 0), (half, half), (0, 0)))
    return sum(up[:, k:k + s] * w[k] for k in range(CONV_K))


def gated_short_conv(p, w_conv):
    gb, gc, v = jnp.split(p, 3, axis=-1)
    return gb * short_conv(gc * v, w_conv)


def mla_project(p, q_norm, w_qb, kv_norm, w_kvb):
    b, s = p.shape[:2]
    cq, ckv, k_rope = jnp.split(p, [MLA_Q_LORA, MLA_Q_LORA + MLA_KV_LORA], axis=-1)
    q = (rmsnorm(cq, q_norm) @ w_qb).reshape(b, s, MLA_HEADS, MLA_NOPE + MLA_ROPE)
    kv = (rmsnorm(ckv, kv_norm) @ w_kvb).reshape(b, s, MLA_HEADS, MLA_NOPE + MLA_V)
    return q[..., :MLA_NOPE], q[..., MLA_NOPE:], kv[..., :MLA_NOPE], k_rope, kv[..., MLA_NOPE:]


def mla_core(qn, qr, kn, kr, v):
    s = (jnp.einsum("bqhd,bkhd->bhqk", qn, kn)
         + jnp.einsum("bqhd,bkd->bhqk", qr, kr)).astype(jnp.float32) * MLA_SCALE
    pr = jax.nn.softmax(s, axis=-1).astype(v.dtype)
    return jnp.einsum("bhqk,bkhd->bqhd", pr, v)


def mla_latent(qn, qr, kn, kr, v):
    b, s = qn.shape[:2]
    nblk = s // BLOCK

    def to_blocks(t):
        return jnp.moveaxis(t.reshape(b, nblk, BLOCK, *t.shape[2:]), 1, 0)

    out = lax.map(lambda qb: mla_core(qb[0], qb[1], kn, kr, v), (to_blocks(qn), to_blocks(qr)))
    return jnp.moveaxis(out, 0, 1).reshape(b, s, MLA_HEADS * MLA_V)


def gqa_project(p):
    b, s = p.shape[:2]
    q, k, v = jnp.split(p, [GQA_HEADS * GQA_HEAD_DIM, (GQA_HEADS + GQA_KV_HEADS) * GQA_HEAD_DIM], axis=-1)
    return (q.reshape(b, s, GQA_HEADS, GQA_HEAD_DIM),
            k.reshape(b, s, GQA_KV_HEADS, GQA_HEAD_DIM),
            v.reshape(b, s, GQA_KV_HEADS, GQA_HEAD_DIM))


def sink_logits(sink, shape):
    return jnp.broadcast_to(sink.astype(jnp.float32).reshape(GQA_KV_HEADS, GQA_GROUP, 1, 1), shape)


def window_attend(q, k, v, ck, cv, sink):
    b, s = q.shape[:2]
    nblk = s // BLOCK
    qb = q.reshape(b, nblk, BLOCK, GQA_KV_HEADS, GQA_GROUP, GQA_HEAD_DIM)

    def band(t):
        tp = jnp.pad(t, ((0, 0), (BLOCK, BLOCK), (0, 0), (0, 0)))
        tp = tp.reshape(b, nblk + 2, BLOCK, GQA_KV_HEADS, GQA_HEAD_DIM)
        return jnp.concatenate([tp[:, :-2], tp[:, 1:-1], tp[:, 2:]], axis=2)

    kb, vb = band(k), band(v)
    blk = jnp.arange(nblk)[:, None, None]
    qi = blk * BLOCK + jnp.arange(BLOCK)[None, :, None]
    kj = (blk - 1) * BLOCK + jnp.arange(3 * BLOCK)[None, None, :]
    valid = (jnp.abs(kj - qi) <= WINDOW) & (kj >= 0) & (kj < s)
    s_loc = jnp.einsum("bnqkgd,bnpkd->bnkgqp", qb, kb).astype(jnp.float32) * GQA_SCALE
    s_loc = jnp.where(valid[None, :, None, None], s_loc, -jnp.inf)
    s_ctx = jnp.einsum("bnqkgd,bpkd->bnkgqp", qb, ck).astype(jnp.float32) * GQA_SCALE
    s_snk = sink_logits(sink, s_loc.shape[:-1] + (1,))
    pr = jax.nn.softmax(jnp.concatenate([s_loc, s_ctx, s_snk], axis=-1), axis=-1).astype(v.dtype)
    n_loc = 3 * BLOCK
    o = (jnp.einsum("bnkgqp,bnpkd->bnqkgd", pr[..., :n_loc], vb)
         + jnp.einsum("bnkgqp,bpkd->bnqkgd", pr[..., n_loc:n_loc + ck.shape[1]], cv))
    return o.reshape(b, s, GQA_HEADS * GQA_HEAD_DIM)


def ctx_window_attend(cq, ck, cv, sink):
    b, n = cq.shape[:2]
    qg = cq.reshape(b, n, GQA_KV_HEADS, GQA_GROUP, GQA_HEAD_DIM)
    sc = jnp.einsum("bqkgd,bpkd->bkgqp", qg, ck).astype(jnp.float32) * GQA_SCALE
    s_snk = sink_logits(sink, sc.shape[:-1] + (1,))
    pr = jax.nn.softmax(jnp.concatenate([sc, s_snk], axis=-1), axis=-1)[..., :n].astype(cv.dtype)
    o = jnp.einsum("bkgqp,bpkd->bqkgd", pr, cv)
    return o.reshape(b, n, GQA_HEADS * GQA_HEAD_DIM)


def merge_branches(y_conv, y_mla, y_gqa, p_gate, w_bc, w_bm, w_bg, w_out):
    g_c, g_m, g_g = jnp.split(p_gate, N_BRANCH, axis=-1)
    merged = (jax.nn.sigmoid(g_c) * (y_conv @ w_bc)
              + jax.nn.sigmoid(g_m) * (y_mla @ w_bm)
              + jax.nn.sigmoid(g_g) * (y_gqa @ w_bg))
    return merged @ w_out


def token_mixing(px, pc, row, col, conv_w, mla_q_norm, mla_w_qb, mla_kv_norm, mla_w_kvb,
                 gqa_sink, w_bc, w_bm, w_bg, w_out, with_ctx):
    x_conv, x_mla, x_gqa, x_gate = jnp.split(px, IN_SPLITS, axis=-1)
    c_conv, c_mla, c_gqa, c_gate = jnp.split(pc, IN_SPLITS, axis=-1)

    ya_x = gated_short_conv(x_conv, conv_w)

    qn, qr, kn, kr, v = mla_project(x_mla, mla_q_norm, mla_w_qb, mla_kv_norm, mla_w_kvb)
    qr = rope_2d(qr, row, col)
    kr = rope_2d(kr[:, :, None, :], row, col)[:, :, 0, :]
    cqn, cqr, ckn, ckr, cv = mla_project(c_mla, mla_q_norm, mla_w_qb, mla_kv_norm, mla_w_kvb)
    yb_x = mla_latent(qn, qr,
                      jnp.concatenate([kn, ckn], axis=1),
                      jnp.concatenate([kr, ckr], axis=1),
                      jnp.concatenate([v, cv], axis=1))

    q, k, vg = gqa_project(x_gqa)
    q, k = rope_2d(q, row, col), rope_2d(k, row, col)
    cq, ck, cvg = gqa_project(c_gqa)
    yc_x = window_attend(q, k, vg, ck, cvg, gqa_sink)

    out_x = merge_branches(ya_x, yb_x, yc_x, x_gate, w_bc, w_bm, w_bg, w_out)
    if not with_ctx:
        return out_x, None

    b, n = pc.shape[:2]
    ya_c = gated_short_conv(c_conv, conv_w)
    yb_c = mla_core(cqn, cqr, ckn, ckr, cv).reshape(b, n, MLA_HEADS * MLA_V)
    yc_c = ctx_window_attend(cq, ck, cvg, gqa_sink)
    out_c = merge_branches(ya_c, yb_c, yc_c, c_gate, w_bc, w_bm, w_bg, w_out)
    return out_x, out_c


def setup_inputs(seed: int = 0) -> dict:
    key = jax.random.key(seed)
    ks = jax.random.split(key, 25)

    def nrm(i, shape, scale):
        return jax.random.normal(ks[i], shape, jnp.float32) * scale

    def gain(i, shape):
        return 1.0 + nrm(i, shape, 0.01)

    L, D = DEPTH, D_MODEL
    return {
        "x": nrm(0, (BATCH, SEQ, D), 1.0),
        "c": nrm(1, (BATCH, D), 1.0),
        "ctx": nrm(2, (BATCH, CTX_LEN, D), 1.0),
        "c_ctx": nrm(3, (D,), 1.0),
        "ada_w": nrm(4, (L, D, N_MOD * D), 0.5 * D ** -0.5),
        "ada_b": nrm(5, (L, N_MOD * D), 0.01),
        "ffn1_norm": gain(6, (L, D)),
        "ffn1_w_gu": nrm(7, (L, D, 2 * D_FF), D ** -0.5),
        "ffn1_w_down": nrm(8, (L, D_FF, D), D_FF ** -0.5),
        "mix_norm": gain(9, (L, D)),
        "w_in": nrm(10, (L, D, IN_COLS), D ** -0.5),
        "conv_w": nrm(11, (L, CONV_K, CONV_WIDTH), CONV_K ** -0.5),
        "mla_q_norm": gain(12, (L, MLA_Q_LORA)),
        "mla_w_qb": nrm(13, (L, MLA_Q_LORA, MLA_HEADS * (MLA_NOPE + MLA_ROPE)), MLA_Q_LORA ** -0.5),
        "mla_kv_norm": gain(14, (L, MLA_KV_LORA)),
        "mla_w_kvb": nrm(15, (L, MLA_KV_LORA, MLA_HEADS * (MLA_NOPE + MLA_V)), MLA_KV_LORA ** -0.5),
        "gqa_sink": nrm(16, (L, GQA_HEADS), 0.5),
        "w_branch_conv": nrm(17, (L, CONV_WIDTH, D), CONV_WIDTH ** -0.5),
        "w_branch_mla": nrm(18, (L, MLA_HEADS * MLA_V, D), (MLA_HEADS * MLA_V) ** -0.5),
        "w_branch_gqa": nrm(19, (L, GQA_HEADS * GQA_HEAD_DIM, D), (GQA_HEADS * GQA_HEAD_DIM) ** -0.5),
        "w_out": nrm(20, (L, D, D), D ** -0.5),
        "ffn2_norm": gain(21, (L, D)),
        "ffn2_w_gu": nrm(22, (L, D, 2 * D_FF), D ** -0.5),
        "ffn2_w_down": nrm(23, (L, D_FF, D), D_FF ** -0.5),
        "final_norm": gain(24, (D,)),
    }


def reference(x, c, ctx, c_ctx, ada_w, ada_b, ffn1_norm, ffn1_w_gu, ffn1_w_down, mix_norm, w_in,
              conv_w, mla_q_norm, mla_w_qb, mla_kv_norm, mla_w_kvb, gqa_sink, w_branch_conv,
              w_branch_mla, w_branch_gqa, w_out, ffn2_norm, ffn2_w_gu, ffn2_w_down, final_norm):
    seq = x.shape[1]
    n_rows = seq // GRID_W
    row = jnp.repeat(jnp.arange(n_rows, dtype=jnp.int32), GRID_W)
    col = jnp.tile(jnp.arange(GRID_W, dtype=jnp.int32), n_rows)

    silu_c = jax.nn.silu(c)
    silu_cc = jax.nn.silu(c_ctx)[None, :]
    hx, hc = x, ctx
    for l in range(DEPTH):
        with_ctx = l < DEPTH - 1
        mx = [m[:, None, :] for m in jnp.split(silu_c @ ada_w[l] + ada_b[l], N_MOD, axis=-1)]
        mc = [m[:, None, :] for m in jnp.split(silu_cc @ ada_w[l] + ada_b[l], N_MOD, axis=-1)]

        hx = hx + 0.5 * mx[2] * swiglu(modulate(rmsnorm(hx, ffn1_norm[l]), mx[0], mx[1]),
                                       ffn1_w_gu[l], ffn1_w_down[l])
        hc = hc + 0.5 * mc[2] * swiglu(modulate(rmsnorm(hc, ffn1_norm[l]), mc[0], mc[1]),
                                       ffn1_w_gu[l], ffn1_w_down[l])

        px = modulate(rmsnorm(hx, mix_norm[l]), mx[3], mx[4]) @ w_in[l]
        pc = modulate(rmsnorm(hc, mix_norm[l]), mc[3], mc[4]) @ w_in[l]
        yx, yc = token_mixing(px, pc, row, col, conv_w[l], mla_q_norm[l], mla_w_qb[l],
                              mla_kv_norm[l], mla_w_kvb[l], gqa_sink[l], w_branch_conv[l],
                              w_branch_mla[l], w_branch_gqa[l], w_out[l], with_ctx)
        hx = hx + mx[5] * yx

        hx = hx + 0.5 * mx[8] * swiglu(modulate(rmsnorm(hx, ffn2_norm[l]), mx[6], mx[7]),
                                       ffn2_w_gu[l], ffn2_w_down[l])
        if with_ctx:
            hc = hc + mc[5] * yc
            hc = hc + 0.5 * mc[8] * swiglu(modulate(rmsnorm(hc, ffn2_norm[l]), mc[6], mc[7]),
                                           ffn2_w_gu[l], ffn2_w_down[l])
    return rmsnorm(hx, final_norm)
```

```cpp
#include <hip/hip_runtime.h>
#include <cstdio>
#include <cstdint>

#ifndef MK_ONE_LAUNCH
#define MK_ONE_LAUNCH 1
#endif

#define LAS __attribute__((address_space(3)))
#define GAS __attribute__((address_space(1)))
typedef unsigned short bf16_t;
typedef short bf16x8 __attribute__((ext_vector_type(8)));
typedef short s16x4 __attribute__((ext_vector_type(4)));
typedef float f32x4 __attribute__((ext_vector_type(4)));
typedef float f32x2 __attribute__((ext_vector_type(2)));
typedef float f32x16 __attribute__((ext_vector_type(16)));
typedef unsigned u32x4 __attribute__((ext_vector_type(4)));
typedef unsigned u32x2 __attribute__((ext_vector_type(2)));

constexpr int DM = 2048, NBATCH = 4, SEQ = 4096, TL = NBATCH * SEQ, CTXL = 256, TC = NBATCH * CTXL, TT = TL + TC;
constexpr int FF = 5632, NMOD = 9, MODW = NMOD * DM;
constexpr int INC = 11584, INP = 11776;
constexpr int OFF_MLA = 3072, OFF_GQA = 3904, OFF_GATE = 5440;
constexpr float EPS = 1e-6f;
constexpr float LOG2E = 1.4426950408889634f;

constexpr size_t MiB = 1u << 20;
constexpr size_t WS_CTL = 0, CTL_ZERO_BYTES = 1 * MiB;
constexpr size_t WS_MOD = 1 * MiB;
constexpr size_t WS_ROPE = WS_MOD + 768 * 1024;
constexpr size_t WS_SSQ = 2 * MiB;
constexpr size_t WS_W = 4 * MiB;
constexpr size_t W_GU1 = WS_W, W_D1 = W_GU1 + 44 * MiB, W_IN = W_D1 + 22 * MiB, W_QB = W_IN + 46 * MiB, W_KVB = W_QB + 2 * MiB,
                 W_BR = W_KVB + 2 * MiB, W_OUT = W_BR + 12 * MiB, W_GU2 = W_OUT + 8 * MiB, W_D2 = W_GU2 + 44 * MiB, W_END = W_D2 + 22 * MiB;
constexpr size_t WS_H = 208 * MiB;
constexpr size_t WS_XN = WS_H + 136 * MiB;
constexpr size_t WS_BIG = WS_XN + 68 * MiB;
constexpr size_t WS_PCONV = WS_BIG, WS_PMLA = WS_PCONV + 102 * MiB, WS_PGQA = WS_PMLA + 34 * MiB, WS_PGATE = WS_PGQA + 51 * MiB;
constexpr size_t WS_QMLA = WS_PGATE + 204 * MiB + 1 * MiB;
constexpr size_t WS_KMLA = WS_QMLA + 52 * MiB;
constexpr size_t WS_VMLA = WS_KMLA + 52 * MiB;
constexpr size_t WS_W2 = WS_VMLA + 36 * MiB;
constexpr size_t W2_SHIFT = WS_W2 - WS_W;
constexpr size_t WS_PART = WS_W2 + 204 * MiB;
constexpr size_t WS_END = WS_PART + 32 * MiB;
static_assert(W_END <= WS_H, "weights overlap h");
static_assert(WS_END <= 1200ull * MiB, "workspace too large");

constexpr int CW_TMO = 0, CW_BAR = 4096, CW_FILL = 8192;

constexpr int RING_BYTES = 131072, LDSCTL_OFF = 143360, MISC_OFF = LDSCTL_OFF + 320, LDS_BYTES = 147456;
constexpr int NWAVES = 8;

#define LDS_WAIT() asm volatile("s_waitcnt lgkmcnt(0)" ::: "memory")
#define VM_WAIT() asm volatile("s_waitcnt vmcnt(0)" ::: "memory")
__device__ __forceinline__ unsigned f2bf(float f) { unsigned u = __builtin_bit_cast(unsigned, f); return (u + 0x7fffu + ((u >> 16) & 1u)) >> 16; }
__device__ __forceinline__ unsigned pk2(float lo, float hi) { return f2bf(lo) | (f2bf(hi) << 16); }
__device__ __forceinline__ unsigned cvt_pk_bf16(float lo, float hi) { unsigned r; asm volatile("v_cvt_pk_bf16_f32 %0, %1, %2" : "=v"(r) : "v"(lo), "v"(hi)); return r; }
__device__ __forceinline__ float bf2f(unsigned short b) { return __builtin_bit_cast(float, (unsigned)b << 16); }
__device__ __forceinline__ float bflo(unsigned w) { return __builtin_bit_cast(float, w << 16); }
__device__ __forceinline__ float bfhi(unsigned w) { return __builtin_bit_cast(float, w & 0xffff0000u); }
__device__ __forceinline__ float shflx(float v, int o, int lane) { return __builtin_bit_cast(float, __builtin_amdgcn_ds_bpermute((lane ^ o) << 2, __builtin_bit_cast(int, v))); }
__device__ __forceinline__ float wave_sum(float v, int lane) {
#pragma unroll
    for (int o = 1; o < 64; o <<= 1) v += shflx(v, o, lane);
    return v;
}
__device__ __forceinline__ float silu_f(float x) { return x * __builtin_amdgcn_rcpf(1.0f + __builtin_amdgcn_exp2f(-x * LOG2E)); }
__device__ __forceinline__ float sigmoid_f(float x) { return __builtin_amdgcn_rcpf(1.0f + __builtin_amdgcn_exp2f(-x * LOG2E)); }

namespace pg8 {
constexpr int BM = 256, BK = 64, HALF = 128, HTB = HALF * BK * 2, STAGE_BYTES = 8 * HTB, NXCD = 8, WGM = 4;
__host__ __device__ __forceinline__ int lds_byte(int r, int c) { const int st = (r >> 4) * 2 + (c >> 5), rr = r & 15, cc = c & 31, ob = rr * 64 + cc * 2; return st * 1024 + (ob ^ (((ob >> 9) & 1) << 5)); }
__host__ __device__ __forceinline__ void stage_rc(int b, int& R, int& C) { const int st = b / 1024, sb = b % 1024, swz = sb ^ (((sb >> 9) & 1) << 5); R = (st >> 1) * 16 + swz / 64; C = (st & 1) * 32 + (swz % 64) / 2; }
__host__ __device__ __forceinline__ int perm32(int rho) { const int n = rho >> 4, i = rho & 15; return 8 * (i >> 2) + 4 * n + (i & 3); }

struct Unit { int pm, pn, z, k0, nt; };
struct Gemm { const bf16_t* A; const bf16_t* Bt; int lda, ldb, K; size_t zA, zB; };

struct StaticOrder {
    int nM, nN, nwg, G, c, ntk;
    __device__ void init(int nM_, int nN_, int G_, int c_, int K_) { nM = nM_; nN = nN_; nwg = nM * nN; G = G_; c = c_; ntk = K_ / BK; }
    __device__ bool tile(int i, Unit& u) const {
        const long L = (long)i * G + c; if (L >= nwg) return false;
        int wgid = (int)L; { const int q = nwg / NXCD, r = nwg % NXCD, xcd = wgid % NXCD, off = wgid / NXCD; wgid = (xcd < r ? xcd * (q + 1) : r * (q + 1) + (xcd - r) * q) + off; }
        const int nig = WGM * nN, gid = wgid / nig, fm = gid * WGM, gsz = (nM - fm) < WGM ? (nM - fm) : WGM;
        u.pm = fm + ((wgid % nig) % gsz); u.pn = (wgid % nig) / gsz; u.z = 0; u.k0 = 0; u.nt = ntk; return true;
    }
    __device__ bool next(int i, Unit& u) const { return tile(i, u); }
};
struct SplitOrder : StaticOrder {
    int ks;
    __device__ bool next(int i, Unit& u) const {
        const long L = (long)i * G + c;
        if (L < nwg) return tile(i, u);
        const int j = (int)(L - nwg); const int per = nN * (ks > 0 ? ks : 1), r = j % per, kz = r % (ks > 0 ? ks : 1), nts = ntk / (ks > 0 ? ks : 1);
        Unit t; t.pm = 64 + j / per; t.pn = r / (ks > 0 ? ks : 1); t.z = kz; t.nt = nts; t.k0 = kz * nts * BK; u = t;
        return ks > 0 && j < 4 * per;
    }
};
struct WinOrder : StaticOrder {
    bool trim;
    __device__ bool next(int i, Unit& u) const {
        if (!trim) return tile(i, u);
        const long L = (long)i * G + c;
        if (L < nwg) return tile(i, u);
        const int j = (int)(L - nwg); const int t = j % 6;
        Unit w; w.pm = 64 + j / 6; w.pn = t < 4 ? 12 + t : 16 + t; w.z = 0; w.k0 = 0; w.nt = ntk; u = w; return j < 24;
    }
};
struct MergeOrder : StaticOrder {
    __device__ bool next(int i, Unit& u) const { if (!tile(i / 3, u)) return false; u.z = i % 3; return true; }
};

template <class Epi, class Sched, bool ALIGN_EPI>
__device__ __forceinline__ void gemm_phase(LAS unsigned char* lds, const Gemm g, const Sched& S, const Epi& E) {
    int tid = threadIdx.x; asm volatile("" : "+v"(tid));
    const int wid = __builtin_amdgcn_readfirstlane(tid >> 6), lane = tid & 63, wr = wid >> 2, wc = wid & 3, fr = lane & 15, fq = lane >> 4;
    unsigned voffA[2], voffB[2];
#pragma unroll
    for (int i = 0; i < 2; ++i) { int R, C; stage_rc(tid * 16 + i * 8192, R, C); const int Rb = Epi::PERM ? ((R & ~31) + perm32(R & 31)) : R;
        voffA[i] = (unsigned)(R * g.lda + C) * 2u; voffB[i] = (unsigned)(Rb * g.ldb + C) * 2u; }
    const size_t kstep = (size_t)(BK * 2);
    const size_t hstepA = (size_t)HALF * g.lda * 2, hstepB = (size_t)HALF * g.ldb * 2;
    const size_t tstepA = 2 * hstepA, tstepB = 2 * hstepB;
    const unsigned ldsw = (unsigned)wid * 1024u;
    const int aoff = lds_byte(wr * 64 + fr, fq * 8), boff = lds_byte(wc * 32 + fr, fq * 8);
#define PG8_UA(u) ((const char*)g.A + (size_t)(u).pm * tstepA + (size_t)(u).z * g.zA + (size_t)(u).k0 * 2)
#define PG8_UB(u) ((const char*)g.Bt + (size_t)(u).pn * tstepB + (size_t)(u).z * g.zB + (size_t)(u).k0 * 2)
#define PG8_SA(b, h) (((b) * 2 + (h)) * HTB)
#define PG8_SB(b, h) ((4 + (b) * 2 + (h)) * HTB)
#define PG8_STAGE(bufoff, gbase, voff) do { _Pragma("unroll") for (int _i = 0; _i < 2; ++_i) \
        __builtin_amdgcn_global_load_lds((const unsigned*)((const char*)(gbase) + (voff)[_i]), (LAS unsigned*)(lds + (bufoff) + ldsw + _i * 8192), 16, 0, 0); } while (0)
#define PG8_LDA(dst, b, h) do { _Pragma("unroll") for (int m = 0; m < 4; ++m) _Pragma("unroll") for (int k = 0; k < 2; ++k) dst[m][k] = *(const LAS bf16x8*)(lds + PG8_SA(b, h) + aoff + m * 2048 + k * 1024); } while (0)
#define PG8_LDB(dst, b, h) do { _Pragma("unroll") for (int n = 0; n < 2; ++n) _Pragma("unroll") for (int k = 0; k < 2; ++k) dst[n][k] = *(const LAS bf16x8*)(lds + PG8_SB(b, h) + boff + n * 2048 + k * 1024); } while (0)
#define PG8_MMA(ai, bj, At, Bt) do { __builtin_amdgcn_s_setprio(1); _Pragma("unroll") for (int m = 0; m < 4; ++m) _Pragma("unroll") for (int n = 0; n < 2; ++n) _Pragma("unroll") for (int k = 0; k < 2; ++k) \
        acc[ai][bj][m][n] = __builtin_amdgcn_mfma_f32_16x16x32_bf16(Bt[n][k], At[m][k], acc[ai][bj][m][n], 0, 0, 0); __builtin_amdgcn_s_setprio(0); } while (0)
#define PG8_WAIT_V(n) asm volatile("s_waitcnt vmcnt(" #n ")" ::: "memory")
#define PG8_WAIT_L(n) asm volatile("s_waitcnt lgkmcnt(" #n ")" ::: "memory")
#define PG8_BAR __builtin_amdgcn_s_barrier()
#define PG8_SCHED __builtin_amdgcn_sched_barrier(0)
    Unit cur, nxt; int ui = 0;
    if (!S.next(0, cur)) return;
    f32x4 acc[2][2][4][2];
#pragma unroll
    for (int a = 0; a < 2; ++a)
#pragma unroll
        for (int b = 0; b < 2; ++b)
#pragma unroll
            for (int m = 0; m < 4; ++m)
#pragma unroll
                for (int n = 0; n < 2; ++n) acc[a][b][m][n] = (f32x4){0.f, 0.f, 0.f, 0.f};
    bf16x8 At[4][2], B0[2][2], B1[2][2];
    const char* cA = PG8_UA(cur); const char* cB = PG8_UB(cur);
    PG8_STAGE(PG8_SB(0, 0), cB, voffB); PG8_STAGE(PG8_SB(0, 1), cB + hstepB, voffB); PG8_STAGE(PG8_SA(0, 0), cA, voffA); PG8_STAGE(PG8_SA(0, 1), cA + hstepA, voffA);
    if (wr == 1) PG8_BAR;
    PG8_WAIT_V(2); PG8_BAR;
    PG8_STAGE(PG8_SB(1, 0), cB + kstep, voffB); PG8_STAGE(PG8_SA(1, 0), cA + kstep, voffA); PG8_STAGE(PG8_SB(1, 1), cB + hstepB + kstep, voffB);
    PG8_WAIT_V(6); PG8_BAR;
    for (;;) {
        const bool has_next = S.next(ui + 1, nxt);
        const char* nA = has_next ? PG8_UA(nxt) : cA; const char* nB = has_next ? PG8_UB(nxt) : cB;
        int nt = __builtin_amdgcn_readfirstlane(cur.nt); asm volatile("" : "+s"(nt));
#pragma nounroll
        for (int t = 0; t < nt; t += 2) {
            const bool last = (t == nt - 2);
            const char* a1 = cA + (size_t)(t + 1) * kstep;
            const char* a2 = last ? nA : cA + (size_t)(t + 2) * kstep; const char* b2 = last ? nB : cB + (size_t)(t + 2) * kstep;
            const char* a3 = a2 + kstep; const char* b3 = b2 + kstep;
            PG8_LDB(B0, 0, 0); PG8_LDB(B1, 0, 1); PG8_SCHED; PG8_LDA(At, 0, 0); PG8_STAGE(PG8_SA(1, 1), a1 + hstepA, voffA);
            PG8_WAIT_V(8); PG8_WAIT_L(0); PG8_BAR; PG8_MMA(0, 0, At, B0); PG8_MMA(0, 1, At, B1); PG8_BAR; PG8_SCHED;
            PG8_LDA(At, 0, 1); PG8_STAGE(PG8_SB(0, 0), b2, voffB); PG8_STAGE(PG8_SB(0, 1), b2 + hstepB, voffB); PG8_STAGE(PG8_SA(0, 0), a2, voffA);
            PG8_WAIT_V(8); PG8_WAIT_L(0); PG8_BAR; PG8_MMA(1, 0, At, B0); PG8_MMA(1, 1, At, B1); PG8_BAR; PG8_SCHED;
            PG8_LDB(B0, 1, 0); PG8_LDB(B1, 1, 1); PG8_SCHED; PG8_LDA(At, 1, 0); PG8_STAGE(PG8_SA(0, 1), a2 + hstepA, voffA);
            PG8_WAIT_V(8); PG8_WAIT_L(0); PG8_BAR; PG8_MMA(0, 0, At, B0); PG8_MMA(0, 1, At, B1); PG8_BAR; PG8_SCHED;
            PG8_LDA(At, 1, 1); PG8_STAGE(PG8_SB(1, 0), b3, voffB); PG8_STAGE(PG8_SB(1, 1), b3 + hstepB, voffB); PG8_STAGE(PG8_SA(1, 0), a3, voffA);
            PG8_WAIT_V(8); PG8_WAIT_L(0); PG8_BAR; PG8_MMA(1, 0, At, B0); PG8_MMA(1, 1, At, B1); PG8_BAR; PG8_SCHED;
        }
        if constexpr (ALIGN_EPI) { if (wr == 0) PG8_BAR; }
        { int fr_ = fr, fq_ = fq; asm volatile("" : "+v"(fr_), "+v"(fq_));
          E(acc, cur, wr, wc, fr_, fq_); }
        if (!has_next) break;
        if (!(Epi::KEEP && cur.z < 2)) {
#pragma unroll
        for (int a = 0; a < 2; ++a)
#pragma unroll
            for (int b = 0; b < 2; ++b)
#pragma unroll
                for (int m = 0; m < 4; ++m)
#pragma unroll
                    for (int n = 0; n < 2; ++n) acc[a][b][m][n] = (f32x4){0.f, 0.f, 0.f, 0.f};
        }
        cur = nxt; cA = nA; cB = nB; ++ui;
        if constexpr (ALIGN_EPI) { if (wr == 1) PG8_BAR; }
    }
    PG8_WAIT_V(0);
    if constexpr (!ALIGN_EPI) { if (wr == 0) PG8_BAR; }
    PG8_BAR;
#undef PG8_UA
#undef PG8_UB
#undef PG8_SA
#undef PG8_SB
#undef PG8_STAGE
#undef PG8_LDA
#undef PG8_LDB
#undef PG8_MMA
#undef PG8_WAIT_V
#undef PG8_WAIT_L
#undef PG8_BAR
#undef PG8_SCHED
}

typedef f32x4 (&AccRef)[2][2][4][2];

__device__ __forceinline__ void store8(bf16_t* p, f32x4 v0, f32x4 v1) {
    u32x4 w; w.x = cvt_pk_bf16(v0[0], v0[1]); w.y = cvt_pk_bf16(v0[2], v0[3]); w.z = cvt_pk_bf16(v1[0], v1[1]); w.w = cvt_pk_bf16(v1[2], v1[3]);
    *(u32x4*)p = w;
}
__device__ __forceinline__ void store4(bf16_t* p, f32x4 v) { u32x2 w; w.x = cvt_pk_bf16(v[0], v[1]); w.y = cvt_pk_bf16(v[2], v[3]); *(u32x2*)p = w; }

struct EpiSwiGLU {
    static constexpr bool PERM = true, KEEP = false;
    bf16_t* O;
    __device__ __forceinline__ void operator()(AccRef acc, const Unit& u, int wr, int wc, int fr, int fq) const {
        const int row0 = u.pm * BM + wr * 64 + fr, col0 = u.pn * 128 + wc * 32 + 8 * fq;
#pragma unroll
        for (int ai = 0; ai < 2; ++ai)
#pragma unroll
            for (int m = 0; m < 4; ++m) {
                f32x4 h0, h1;
#pragma unroll
                for (int e = 0; e < 4; ++e) { h0[e] = silu_f(acc[ai][0][m][0][e]) * acc[ai][1][m][0][e]; h1[e] = silu_f(acc[ai][0][m][1][e]) * acc[ai][1][m][1][e]; }
                store8(O + (size_t)(row0 + ai * HALF + m * 16) * FF + col0, h0, h1);
            }
    }
};

struct EpiResid {
    static constexpr bool PERM = false, KEEP = false;
    const float* base_lat; const float* base_ctx; float* out; const float* modl; int midx; float coef;
    float* part;
    __device__ __forceinline__ void operator()(AccRef acc, const Unit& u, int wr, int wc, int fr, int fq) const {
        const bool split = part != nullptr && u.pm >= 64;
        const int mrow = u.pm < 64 ? (u.pm >> 4) : 4;
        const float* mp = modl + (size_t)mrow * MODW + midx * DM;
        const unsigned long long slab = (unsigned long long)part + ((size_t)u.z * TC + (size_t)(u.pm - 64) * BM) * DM * 4;
        const unsigned long long ba = split ? slab : (unsigned long long)base_lat + (size_t)u.pm * BM * DM * 4;
        const unsigned long long oa = split ? slab : (unsigned long long)out + (size_t)u.pm * BM * DM * 4;
        const float* bp = (const float*)(const GAS float*)ba; float* op = (float*)(GAS float*)oa;
        const int odd = fr & 1;
        const int colo = u.pn * BM + wc * 32 + 4 * fq;
        const int col0 = colo + 16 * odd;
        f32x4 gv[2][2];
#pragma unroll
        for (int bj = 0; bj < 2; ++bj)
#pragma unroll
            for (int n = 0; n < 2; ++n) { gv[bj][n] = *(const f32x4*)(mp + colo + bj * HALF + n * 16) * coef; if (split) gv[bj][n] = (f32x4){1.f, 1.f, 1.f, 1.f}; }
#pragma unroll
        for (int ai = 0; ai < 2; ++ai) {
            f32x4 b[4][2][2];
#pragma unroll
            for (int m = 0; m < 4; ++m) { const size_t off = (size_t)(ai * HALF + wr * 64 + m * 16 + (fr & ~1)) * DM + col0;
#pragma unroll
                for (int bj = 0; bj < 2; ++bj)
#pragma unroll
                    for (int pr = 0; pr < 2; ++pr) { b[m][bj][pr] = (f32x4){0.f, 0.f, 0.f, 0.f}; if (!split) b[m][bj][pr] = *(const f32x4*)(bp + off + (size_t)pr * DM + bj * HALF); } }
            asm volatile("" ::: "memory");
#pragma unroll
            for (int m = 0; m < 4; ++m) { const size_t off = (size_t)(ai * HALF + wr * 64 + m * 16 + (fr & ~1)) * DM + col0;
#pragma unroll
                for (int bj = 0; bj < 2; ++bj) {
                    const f32x4 a0 = gv[bj][0] * acc[ai][bj][m][0], a1 = gv[bj][1] * acc[ai][bj][m][1];
                    f32x4 t;
#pragma unroll
                    for (int e = 0; e < 4; ++e) { const float sv = odd ? a0[e] : a1[e];
                        t[e] = __builtin_bit_cast(float, __builtin_amdgcn_mov_dpp(__builtin_bit_cast(int, sv), 0xB1, 0xF, 0xF, true)); }
                    f32x4 p0, p1;
#pragma unroll
                    for (int e = 0; e < 4; ++e) { p0[e] = odd ? t[e] : a0[e]; p1[e] = odd ? a1[e] : t[e]; }
                    *(f32x4*)(op + off + bj * HALF) = b[m][bj][0] + p0;
                    *(f32x4*)(op + off + (size_t)DM + bj * HALF) = b[m][bj][1] + p1; } }
            asm volatile("" ::: "memory");
        }
    }
};

struct EpiWin {
    static constexpr bool PERM = true, KEEP = false;
    bf16_t *pconv, *pmla, *pgqa, *pgate; float* ssq; const float* cos64; const float* sin64;
    __device__ __forceinline__ void plain(AccRef acc, bf16_t* O, int ldc, int colt, const Unit& u, int wr, int wc, int fr, int fq) const {
        const int row0 = u.pm * BM + wr * 64 + fr, col0 = colt + wc * 32 + 8 * fq;
#pragma unroll
        for (int ai = 0; ai < 2; ++ai)
#pragma unroll
            for (int m = 0; m < 4; ++m) { bf16_t* rowp = O + (size_t)(row0 + ai * HALF + m * 16) * ldc + col0;
#pragma unroll
                for (int bj = 0; bj < 2; ++bj) store8(rowp + bj * HALF, acc[ai][bj][m][0], acc[ai][bj][m][1]); }
    }
    __device__ __forceinline__ void operator()(AccRef acc, const Unit& u, int wr, int wc, int fr, int fq) const {
        const int pn = u.pn;
        if (pn < 12) { plain(acc, pconv, 3072, pn * 256, u, wr, wc, fr, fq); }
        else if (pn < 16) {
            plain(acc, pmla, 1024, (pn - 12) * 256, u, wr, wc, fr, fq);
            if (pn < 15) {
#pragma unroll
                for (int ai = 0; ai < 2; ++ai)
#pragma unroll
                    for (int m = 0; m < 4; ++m) { float s = 0.f;
#pragma unroll
                        for (int bj = 0; bj < 2; ++bj)
#pragma unroll
                            for (int n = 0; n < 2; ++n) { const f32x4 x = acc[ai][bj][m][n]; s += (x[0] * x[0] + x[1] * x[1]) + (x[2] * x[2] + x[3] * x[3]); }
                        s += shflx(s, 16, fr + 16 * fq); s += shflx(s, 32, fr + 16 * fq);
                        if (fq == 0) ssq[(size_t)(u.pm * BM + ai * HALF + wr * 64 + m * 16 + fr) * 16 + (pn - 12) * 4 + wc] = s; }
            }
        }
        else if (pn < 21) {
            const bool lat = u.pm < 64; const bool rowtype = wc < 2;
            const int i0 = 16 * (wc & 1) + 4 * fq, d1base = rowtype ? (16 * wc + 4 * fq) : (16 * wc + 4 * fq + 32);
            const int rpos = (4 * u.pm + 2 * 0 + wr) & 63;
#pragma unroll
            for (int ai = 0; ai < 2; ++ai)
#pragma unroll
                for (int m = 0; m < 4; ++m) {
                    f32x4 cs = (f32x4){1.f, 1.f, 1.f, 1.f}, sn = (f32x4){0.f, 0.f, 0.f, 0.f};
                    if (lat) { const int pos = rowtype ? ((rpos + 2 * ai) & 63) : (16 * m + fr); cs = *(const f32x4*)(cos64 + pos * 32 + i0); sn = *(const f32x4*)(sin64 + pos * 32 + i0); }
                    bf16_t* rowp = pgqa + (size_t)(u.pm * BM + ai * HALF + wr * 64 + m * 16 + fr) * 1536 + (2 * (pn - 16)) * 128 + d1base;
#pragma unroll
                    for (int bj = 0; bj < 2; ++bj) { const f32x4 x1 = acc[ai][bj][m][0], x2 = acc[ai][bj][m][1];
                        store4(rowp + bj * 128, x1 * cs - x2 * sn); store4(rowp + bj * 128 + 32, x1 * sn + x2 * cs); }
                }
        }
        else if (pn == 21) { plain(acc, pgqa, 1536, 1280, u, wr, wc, fr, fq); }
        else {
            const int row0 = u.pm * BM + wr * 64 + fr, col0 = (pn - 22) * 256 + wc * 32 + 8 * fq;
#pragma unroll
            for (int ai = 0; ai < 2; ++ai)
#pragma unroll
                for (int m = 0; m < 4; ++m) { bf16_t* rowp = pgate + (size_t)(row0 + ai * HALF + m * 16) * 6144 + col0;
#pragma unroll
                    for (int bj = 0; bj < 2; ++bj) { f32x4 a, b;
#pragma unroll
                        for (int e = 0; e < 4; ++e) { a[e] = sigmoid_f(acc[ai][bj][m][0][e]); b[e] = sigmoid_f(acc[ai][bj][m][1][e]); }
                        store8(rowp + bj * HALF, a, b); } }
        }
    }
};

struct EpiMlaQ {
    static constexpr bool PERM = true, KEEP = false;
    bf16_t* Q; const float* ssq; const float* cos32; const float* sin32;
    __device__ __forceinline__ void operator()(AccRef acc, const Unit& u, int wr, int wc, int fr, int fq) const {
        const int pn = u.pn; const bool lat = u.pm < 64;
        const int rpos = (4 * u.pm + wr) & 63;
        float rq[2][4];
#pragma unroll
        for (int ai = 0; ai < 2; ++ai)
#pragma unroll
            for (int m = 0; m < 4; ++m) { const int row = u.pm * BM + ai * HALF + wr * 64 + m * 16 + fr;
                const f32x4 s0 = *(const f32x4*)(ssq + (size_t)row * 16), s1 = *(const f32x4*)(ssq + (size_t)row * 16 + 4);
                rq[ai][m] = __builtin_amdgcn_rsqf(((s0[0] + s0[1]) + (s0[2] + s0[3]) + (s1[0] + s1[1]) + (s1[2] + s1[3])) * (1.0f / 512.0f) + EPS); }
        if (pn < 4) {
#pragma unroll
            for (int ai = 0; ai < 2; ++ai)
#pragma unroll
                for (int m = 0; m < 4; ++m) { const int row = u.pm * BM + ai * HALF + wr * 64 + m * 16 + fr;
#pragma unroll
                    for (int bj = 0; bj < 2; ++bj) store8(Q + (size_t)row * 1536 + (2 * pn + bj) * 192 + wc * 32 + 8 * fq, acc[ai][bj][m][0] * rq[ai][m], acc[ai][bj][m][1] * rq[ai][m]); }
        } else {
            const bool rowtype = (wc & 1) == 0; const int d1base = rowtype ? 4 * fq : 32 + 4 * fq;
#pragma unroll
            for (int ai = 0; ai < 2; ++ai) {
                f32x4 cs[4], sn[4];
#pragma unroll
                for (int m = 0; m < 4; ++m) { cs[m] = (f32x4){1.f, 1.f, 1.f, 1.f}; sn[m] = (f32x4){0.f, 0.f, 0.f, 0.f};
                    if (lat) { const int pos = rowtype ? ((rpos + 2 * ai) & 63) : (16 * m + fr); cs[m] = *(const f32x4*)(cos32 + pos * 16 + 4 * fq); sn[m] = *(const f32x4*)(sin32 + pos * 16 + 4 * fq); } }
#pragma unroll
                for (int m = 0; m < 4; ++m) { const int row = u.pm * BM + ai * HALF + wr * 64 + m * 16 + fr;
#pragma unroll
                    for (int bj = 0; bj < 2; ++bj) { const int head = 2 * (2 * (pn - 4) + bj) + (wc >> 1);
                        const f32x4 x1 = acc[ai][bj][m][0] * rq[ai][m], x2 = acc[ai][bj][m][1] * rq[ai][m];
                        bf16_t* p = Q + (size_t)row * 1536 + head * 192 + 128 + d1base;
                        store4(p, x1 * cs[m] - x2 * sn[m]); store4(p + 16, x1 * sn[m] + x2 * cs[m]); } }
            }
        }
    }
};
struct EpiMlaKV {
    static constexpr bool PERM = true, KEEP = false;
    bf16_t* KM; bf16_t* VM; const float* ssq;
    __device__ __forceinline__ void operator()(AccRef acc, const Unit& u, int wr, int wc, int fr, int fq) const {
        const int h = u.pn;
        float rk[2][4];
#pragma unroll
        for (int ai = 0; ai < 2; ++ai)
#pragma unroll
            for (int m = 0; m < 4; ++m) { const int row = u.pm * BM + ai * HALF + wr * 64 + m * 16 + fr;
                const f32x4 s0 = *(const f32x4*)(ssq + (size_t)row * 16 + 8);
                rk[ai][m] = __builtin_amdgcn_rsqf(((s0[0] + s0[1]) + (s0[2] + s0[3])) * (1.0f / 256.0f) + EPS); }
#pragma unroll
        for (int ai = 0; ai < 2; ++ai)
#pragma unroll
            for (int m = 0; m < 4; ++m) { const int row = u.pm * BM + ai * HALF + wr * 64 + m * 16 + fr;
                store8(KM + (size_t)row * 1536 + h * 192 + wc * 32 + 8 * fq, acc[ai][0][m][0] * rk[ai][m], acc[ai][0][m][1] * rk[ai][m]);
                store8(VM + (size_t)row * 1024 + h * 128 + wc * 32 + 8 * fq, acc[ai][1][m][0] * rk[ai][m], acc[ai][1][m][1] * rk[ai][m]); }
    }
};
struct EpiMerge {
    static constexpr bool PERM = true, KEEP = true;
    const bf16_t* gate; bf16_t* O;
    __device__ __forceinline__ static f32x4 gclamp(unsigned lo, unsigned hi) { f32x4 g = (f32x4){bflo(lo), bfhi(lo), bflo(hi), bfhi(hi)};
#pragma unroll
        for (int e = 0; e < 4; ++e) g[e] = fmaxf(g[e], 1e-4f);
        return g; }
    __device__ __forceinline__ void operator()(AccRef acc, const Unit& u, int wr, int wc, int fr, int fq) const {
        const int col0 = u.pn * BM + wc * 32 + 8 * fq;
#pragma unroll
        for (int ai = 0; ai < 2; ++ai)
#pragma unroll
            for (int mh = 0; mh < 2; ++mh) {
                u32x4 ga[2][2], gb[2][2];
#pragma unroll
                for (int mm = 0; mm < 2; ++mm) { const int m = mh * 2 + mm; const size_t row = (size_t)(u.pm * BM + ai * HALF + wr * 64 + m * 16 + fr);
#pragma unroll
                    for (int bj = 0; bj < 2; ++bj) { const bf16_t* gp = gate + row * 6144 + u.z * 2048 + col0 + bj * HALF; ga[mm][bj] = *(const u32x4*)gp; gb[mm][bj] = ga[mm][bj]; if (u.z < 2) gb[mm][bj] = *(const u32x4*)(gp + 2048); } }
                asm volatile("" ::: "memory");
#pragma unroll
                for (int mm = 0; mm < 2; ++mm) { const int m = mh * 2 + mm; const size_t row = (size_t)(u.pm * BM + ai * HALF + wr * 64 + m * 16 + fr);
#pragma unroll
                    for (int bj = 0; bj < 2; ++bj) {
                        const f32x4 a0 = gclamp(ga[mm][bj].x, ga[mm][bj].y), a1 = gclamp(ga[mm][bj].z, ga[mm][bj].w);
                        if (u.z < 2) {
                            const f32x4 b0 = gclamp(gb[mm][bj].x, gb[mm][bj].y), b1 = gclamp(gb[mm][bj].z, gb[mm][bj].w);
#pragma unroll
                            for (int e = 0; e < 4; ++e) { acc[ai][bj][m][0][e] *= a0[e] * __builtin_amdgcn_rcpf(b0[e]); acc[ai][bj][m][1][e] *= a1[e] * __builtin_amdgcn_rcpf(b1[e]); }
                        } else store8(O + row * DM + col0 + bj * HALF, acc[ai][bj][m][0] * a0, acc[ai][bj][m][1] * a1);
                    } }
                asm volatile("" ::: "memory");
            }
    }
};
}

namespace att {
constexpr int NW = 8, QBLK = 32, KVBLK = 64;
constexpr int SHM_V = KVBLK * 128 * 2;
#define SBAR() __builtin_amdgcn_sched_barrier(0)
__device__ __forceinline__ int crow(int r, int hi) { return (r & 3) + 8 * (r >> 2) + 4 * hi; }
__device__ __forceinline__ bf16x8 ld8(const bf16_t* p) { return *reinterpret_cast<const bf16x8*>(p); }

template <int DQK> struct SM {
    static constexpr float SCALE = DQK == 192 ? 0.07216878364870322f : 0.08838834764831845f;
    static constexpr float C = SCALE * LOG2E;
    static constexpr float THRS = 8.f / SCALE;
    __device__ static __forceinline__ void partialSM(f32x16& p0, f32x16& p1, float& m_reg, float& mn, float& alpha) {
        float pmax = p0[0];
#pragma unroll
        for (int r = 1; r < 16; ++r) pmax = fmaxf(pmax, p0[r]);
#pragma unroll
        for (int r = 0; r < 16; ++r) pmax = fmaxf(pmax, p1[r]);
        { auto rr = __builtin_amdgcn_permlane32_swap(__float_as_uint(pmax), __float_as_uint(pmax), false, false);
          pmax = fmaxf(__uint_as_float(rr[0]), __uint_as_float(rr[1])); }
        if (__builtin_expect(__all(pmax - m_reg <= THRS), 1)) { mn = m_reg; alpha = 1.f; }
        else { mn = fmaxf(m_reg, pmax); alpha = __builtin_amdgcn_exp2f((m_reg - mn) * C); m_reg = mn; }
        const float mnC = -mn * C;
#pragma unroll
        for (int r = 0; r < 16; ++r) p0[r] = fmaf(p0[r], C, mnC);
#pragma unroll
        for (int r = 0; r < 16; ++r) p1[r] = fmaf(p1[r], C, mnC);
#pragma unroll
        for (int r = 0; r < 16; ++r) p0[r] = __builtin_amdgcn_exp2f(p0[r]);
    }
};
__device__ __forceinline__ void finishSM(f32x16& p0, f32x16& p1, float alpha, float& l_reg, bf16x8& pa0, bf16x8& pa1, bf16x8& pa2, bf16x8& pa3) {
#pragma unroll
    for (int r = 0; r < 16; ++r) p1[r] = __builtin_amdgcn_exp2f(p1[r]);
    float ps = 0;
#pragma unroll
    for (int r = 0; r < 16; ++r) ps += p0[r];
#pragma unroll
    for (int r = 0; r < 16; ++r) ps += p1[r];
    { auto rr = __builtin_amdgcn_permlane32_swap(__float_as_uint(ps), __float_as_uint(ps), false, false);
      ps = __uint_as_float(rr[0]) + __uint_as_float(rr[1]); }
    l_reg = l_reg * alpha + ps;
#define PK4(P, BASE, OUT) do { unsigned a0 = cvt_pk_bf16(P[BASE + 0], P[BASE + 1]), a1 = cvt_pk_bf16(P[BASE + 2], P[BASE + 3]);   \
    unsigned b0 = cvt_pk_bf16(P[BASE + 4], P[BASE + 5]), b1 = cvt_pk_bf16(P[BASE + 6], P[BASE + 7]);                              \
    auto r0 = __builtin_amdgcn_permlane32_swap(a0, b0, false, false); auto r1 = __builtin_amdgcn_permlane32_swap(a1, b1, false, false); \
    u32x4 w = {r0[0], r1[0], r0[1], r1[1]}; OUT = *reinterpret_cast<bf16x8*>(&w); } while (0)
    PK4(p0, 0, pa0); PK4(p0, 8, pa1); PK4(p1, 0, pa2); PK4(p1, 8, pa3);
#undef PK4
}
template <int DQK, int NREG> __device__ __forceinline__ void qkt(f32x16& p0, f32x16& p1, const char* Ks, const bf16x8* qr, const char* qst, int r32, int hi) {
    constexpr int RS = DQK * 2;
    p0 = f32x16{}; p1 = f32x16{};
#pragma unroll
    for (int d0 = 0; d0 < DQK / 16; ++d0) { const int cb = (d0 * 16 + hi * 8) * 2;
        const bf16x8 b0 = *reinterpret_cast<const bf16x8*>(Ks + r32 * RS + (cb ^ ((r32 & 7) << 4)));
        const bf16x8 b1 = *reinterpret_cast<const bf16x8*>(Ks + (32 + r32) * RS + (cb ^ ((r32 & 7) << 4)));
        const bf16x8 q = d0 < NREG ? qr[d0 < NREG ? d0 : 0] : *reinterpret_cast<const bf16x8*>(qst + (d0 - NREG) * 1024);
        p0 = __builtin_amdgcn_mfma_f32_32x32x16_bf16(b0, q, p0, 0, 0, 0);
        p1 = __builtin_amdgcn_mfma_f32_32x32x16_bf16(b1, q, p1, 0, 0, 0); }
}
__device__ __forceinline__ int v_st(int k, int c) { const int kk = (k & ~0xC) | ((k & 4) << 1) | ((k & 8) >> 1); return ((kk >> 3) * 4 + (c >> 5)) * 512 + ((kk & 7) * 32 + (c & 31)) * 2; }
__device__ __forceinline__ int v_rd_base(int lane) { return ((lane & 3) << 3) | (((lane >> 2) & 3) << 6) | (((lane >> 4) & 1) << 5) | (((lane >> 5) & 1) << 8); }
constexpr int v_rd_off(int d0, int ks, int half) { return d0 * 512 + ks * 4096 + half * 2048; }
template <int OFF> __device__ __forceinline__ s16x4 tr_read(int vb) {
    s16x4 r; asm volatile("ds_read_b64_tr_b16 %0, %1 offset:%2" : "=&v"(r) : "v"(vb), "i"(OFF) : "memory"); return r;
}
template <int D0> __device__ __forceinline__ void pv_one(f32x16& od, int vb, bf16x8 pa0, bf16x8 pa1, bf16x8 pa2, bf16x8 pa3) {
    const s16x4 l0 = tr_read<v_rd_off(D0, 0, 0)>(vb), h0 = tr_read<v_rd_off(D0, 0, 1)>(vb), l1 = tr_read<v_rd_off(D0, 1, 0)>(vb), h1 = tr_read<v_rd_off(D0, 1, 1)>(vb);
    const s16x4 l2 = tr_read<v_rd_off(D0, 2, 0)>(vb), h2 = tr_read<v_rd_off(D0, 2, 1)>(vb), l3 = tr_read<v_rd_off(D0, 3, 0)>(vb), h3 = tr_read<v_rd_off(D0, 3, 1)>(vb);
    asm volatile("s_waitcnt lgkmcnt(0)" ::: "memory"); SBAR();
#define PK(L, H) (bf16x8){L[0], L[1], L[2], L[3], H[0], H[1], H[2], H[3]}
    od = __builtin_amdgcn_mfma_f32_32x32x16_bf16(pa0, PK(l0, h0), od, 0, 0, 0);
    od = __builtin_amdgcn_mfma_f32_32x32x16_bf16(pa1, PK(l1, h1), od, 0, 0, 0);
    od = __builtin_amdgcn_mfma_f32_32x32x16_bf16(pa2, PK(l2, h2), od, 0, 0, 0);
    od = __builtin_amdgcn_mfma_f32_32x32x16_bf16(pa3, PK(l3, h3), od, 0, 0, 0);
#undef PK
}
__device__ __forceinline__ void pv_d0(f32x16* o, int vb, bf16x8 pa0, bf16x8 pa1, bf16x8 pa2, bf16x8 pa3) {
    pv_one<0>(o[0], vb, pa0, pa1, pa2, pa3); pv_one<1>(o[1], vb, pa0, pa1, pa2, pa3); pv_one<2>(o[2], vb, pa0, pa1, pa2, pa3); pv_one<3>(o[3], vb, pa0, pa1, pa2, pa3);
}

#ifndef ATT_NREGQ
#define ATT_NREGQ 12
#endif
template <int DQK, int LDQ, int LDK, int LDV, int LDO, bool WINDOW, bool SINK>
__device__ __forceinline__ void attn_unit(const bf16_t* __restrict__ Qb, const bf16_t* __restrict__ Kb, const bf16_t* __restrict__ Vb, bf16_t* __restrict__ Ob,
                                          int rowA0, int nA, int rowB0, int NT, int qpos0, int kposB0, float sinkl2, char* lds) {
    constexpr int RS = DQK * 2, SHM_K = KVBLK * DQK * 2, NKC = DQK / 64, ND0 = DQK / 16, NREG = ND0 > 8 ? ATT_NREGQ : ND0, GPR = DQK / 8;
    using S = SM<DQK>;
    int tid = threadIdx.x; asm volatile("" : "+v"(tid));
    const int wid = __builtin_amdgcn_readfirstlane(tid >> 6), lane = tid & 63, r32 = lane & 31, hi = lane >> 5;
    char* V_lds = lds; char* K_lds = lds + 2 * SHM_V;
    float* ws = (float*)(lds + 2 * SHM_V + 3 * SHM_K) + wid * 64; float* li_l = ws; float* al_l = ws + 32;
    float m_reg = -1e30f, l_reg = 0; f32x16 o[4] = {}; bf16x8 qr[NREG];
    const bf16_t* Qw = Qb + (long)(wid * QBLK + r32) * LDQ + hi * 8;
    char* qst = lds + 2 * SHM_V + 3 * SHM_K + NW * 64 * 4 + wid * ((ND0 - NREG) * 1024) + lane * 16;
#pragma unroll
    for (int d0 = 0; d0 < NREG; ++d0) qr[d0] = ld8(Qw + d0 * 16);
#pragma unroll
    for (int d0 = NREG; d0 < ND0; ++d0) *reinterpret_cast<bf16x8*>(qst + (d0 - NREG) * 1024) = ld8(Qw + d0 * 16);
    unsigned voffK[NKC], voffV[2];
#pragma unroll
    for (int i = 0; i < NKC; ++i) { const int G = (i * 8 + wid) * 64 + lane, r = G / GPR, gp = G - r * GPR, g = gp ^ (r & 7); voffK[i] = (unsigned)(r * LDK + g * 8) * 2u; }
#pragma unroll
    for (int i = 0; i < 2; ++i) { const int G = (i * 8 + wid) * 64 + lane, st = G >> 5, kk = (st >> 2) * 8 + ((G >> 2) & 7), c = (st & 3) * 32 + (G & 3) * 8;
        const int k = (kk & ~0xC) | ((kk & 4) << 1) | ((kk & 8) >> 1); voffV[i] = (unsigned)(k * LDV + c) * 2u; }
    const unsigned ldsw = (unsigned)wid * 1024u;
    LAS unsigned char* Kl = (LAS unsigned char*)K_lds; LAS unsigned char* Vl = (LAS unsigned char*)V_lds;
    const int vb0 = (int)(uintptr_t)V_lds + v_rd_base(lane);
#define KROW(t) ((t) < nA ? rowA0 + (t) * KVBLK : rowB0 + ((t) - nA) * KVBLK)
#define KDMA(t, slot) do { const char* kb_ = (const char*)(Kb + (long)KROW(t) * LDK); _Pragma("unroll") for (int i_ = 0; i_ < NKC; ++i_) \
        __builtin_amdgcn_global_load_lds((const unsigned*)(kb_ + voffK[i_]), (LAS unsigned*)(Kl + (slot) * SHM_K + ldsw + i_ * 8192), 16, 0, 0); } while (0)
#define VDMA(t, slot) do { const char* vb_ = (const char*)(Vb + (long)KROW(t) * LDV); _Pragma("unroll") for (int i_ = 0; i_ < 2; ++i_) \
        __builtin_amdgcn_global_load_lds((const unsigned*)(vb_ + voffV[i_]), (LAS unsigned*)(Vl + (slot) * SHM_V + ldsw + i_ * 8192), 16, 0, 0); } while (0)
#define RESC(a) do { if (__any((a) < 1.f)) { if (hi == 0) al_l[r32] = (a); asm volatile("s_waitcnt lgkmcnt(0)" ::: "memory"); \
    _Pragma("unroll") for (int d = 0; d < 4; ++d) _Pragma("unroll") for (int r = 0; r < 16; ++r) o[d][r] *= al_l[crow(r, hi)]; } } while (0)
#define MASK(P0, P1, t) do { if (WINDOW && (t) >= nA) { const int kj0_ = kposB0 + ((t) - nA) * KVBLK - (qpos0 + wid * QBLK + r32); \
    _Pragma("unroll") for (int r = 0; r < 16; ++r) { const int dk_ = kj0_ + crow(r, hi); if (dk_ > 128 || dk_ < -128) P0[r] = -INFINITY; if (dk_ + 32 > 128 || dk_ + 32 < -128) P1[r] = -INFINITY; } } } while (0)
#define LBAR() do { asm volatile("s_waitcnt lgkmcnt(0)" ::: "memory"); __builtin_amdgcn_s_barrier(); asm volatile("" ::: "memory"); } while (0)
#define STEP_END(more) do { if (more) { if (NKC == 3) asm volatile("s_waitcnt vmcnt(3)" ::: "memory"); else asm volatile("s_waitcnt vmcnt(2)" ::: "memory"); } else asm volatile("s_waitcnt vmcnt(0)" ::: "memory"); \
    LBAR(); { const int t_ = kcur; kcur = knext; knext = kfree; kfree = t_; } vsl ^= 1; } while (0)
#define STEP(j, C0, C1, mnC, alC, P0, P1, alP) do { const bool more_ = (j) + 2 < NT; VDMA(j, vsl); if (more_) KDMA((j) + 2, kfree); SBAR(); \
    qkt<DQK, NREG>(C0, C1, K_lds + kcur * SHM_K, qr, qst, r32, hi); MASK(C0, C1, j); \
    finishSM(P0, P1, alP, l_reg, pa0, pa1, pa2, pa3); SBAR(); \
    pv_d0(o, vb0 + (vsl ^ 1) * SHM_V, pa0, pa1, pa2, pa3); S::partialSM(C0, C1, m_reg, mnC, alC); \
    RESC(alC); STEP_END(more_); } while (0)
    f32x16 pA0, pA1, pB0, pB1; float mnA, mnB, alA, alB; bf16x8 pa0, pa1, pa2, pa3;
    int kcur = 0, knext = 1, kfree = 2, vsl = 0;
    KDMA(0, 0); KDMA(1, 1);
    asm volatile("s_waitcnt vmcnt(0)" ::: "memory"); LBAR();
    { const bool more_ = 2 < NT; VDMA(0, vsl); if (more_) KDMA(2, kfree); SBAR();
      qkt<DQK, NREG>(pA0, pA1, K_lds + kcur * SHM_K, qr, qst, r32, hi); MASK(pA0, pA1, 0); S::partialSM(pA0, pA1, m_reg, mnA, alA);
      STEP_END(more_); }
    for (int j = 1; j + 1 < NT; j += 2) {
        STEP(j, pB0, pB1, mnB, alB, pA0, pA1, alA);
        STEP(j + 1, pA0, pA1, mnA, alA, pB0, pB1, alB);
    }
    STEP(NT - 1, pB0, pB1, mnB, alB, pA0, pA1, alA);
    finishSM(pB0, pB1, alB, l_reg, pa0, pa1, pa2, pa3); SBAR();
    pv_d0(o, vb0 + (vsl ^ 1) * SHM_V, pa0, pa1, pa2, pa3);
    if (SINK) l_reg += __builtin_amdgcn_exp2f(sinkl2 - m_reg * S::C);
    if (hi == 0) li_l[r32] = l_reg; asm volatile("s_waitcnt lgkmcnt(0)" ::: "memory");
    float rli[16];
#pragma unroll
    for (int r = 0; r < 16; ++r) rli[r] = __builtin_amdgcn_rcpf(li_l[crow(r, hi)]);
    bf16_t* Ow = Ob + (long)(wid * QBLK) * LDO;
#pragma unroll
    for (int r = 0; r < 16; ++r) { const int orow = crow(r, hi);
#pragma unroll
        for (int d0 = 0; d0 < 4; ++d0) Ow[(long)orow * LDO + d0 * 32 + r32] = (bf16_t)f2bf(o[d0][r] * rli[r]); }
    __syncthreads();
#undef KROW
#undef KDMA
#undef VDMA
#undef RESC
#undef MASK
#undef STEP
#undef STEP_END
#undef LBAR
}
#undef SBAR
}

#define XB_TMO      128
#define XB_XCNT(j)  (256  + 64 * (j))
#define XB_XSUB(j)  (1280 + 64 * (j))
#define XB_XGEN(j)  (2304 + 64 * (j))
#define XB_TOP      3328
#define XB_TOPGEN   3392
#define XCD_BAR_WORDS 3456
#define XB_SPIN_CAP (1u << 18)
__device__ __forceinline__ unsigned xb_ld(unsigned* p)              { return __hip_atomic_load(p, __ATOMIC_RELAXED, __HIP_MEMORY_SCOPE_AGENT); }
__device__ __forceinline__ unsigned xb_add(unsigned* p, unsigned v) { return __hip_atomic_fetch_add(p, v, __ATOMIC_RELAXED, __HIP_MEMORY_SCOPE_AGENT); }
__device__ __forceinline__ unsigned xb_xcc_id() { return (unsigned)__builtin_amdgcn_s_getreg((3 << 11) | 20) & 0xFu; }
#define XB_SPIN(cond, bar) do { unsigned _sp = 0; while (cond) { __builtin_amdgcn_s_sleep(1); \
    if ((++_sp & 255u) == 0u) { if (xb_ld(&(bar)[XB_TMO])) break; if (_sp > XB_SPIN_CAP) { atomicAdd(&(bar)[XB_TMO], 1u); break; } } } } while (0)
struct XcdBarrier { unsigned* bar; unsigned x; volatile LAS unsigned* st; };
__device__ __forceinline__ XcdBarrier xcd_barrier_post(unsigned* bar, volatile LAS unsigned* st) {
    XcdBarrier b; b.bar = bar; b.x = xb_xcc_id(); b.st = st;
    if (threadIdx.x == 0) (void)xb_add(&bar[XB_XCNT(b.x)], 1u);
    return b;
}
__device__ __forceinline__ void xcd_barrier_complete(unsigned* bar, unsigned x, unsigned& nloc, unsigned& nx) {
    const unsigned G = gridDim.x * gridDim.y * gridDim.z;
    unsigned sum, cnt, mine, sp = 0u;
    for (;;) {
        sum = 0u; cnt = 0u; mine = 0u;
#pragma unroll
        for (unsigned j = 0; j < 16; ++j) { const unsigned c = xb_ld(&bar[XB_XCNT(j)]); sum += c; cnt += (c > 0u) ? 1u : 0u; mine = (j == x) ? c : mine; }
        if (sum == G) break;
        __builtin_amdgcn_s_sleep(1);
        if ((++sp & 255u) == 0u) { if (xb_ld(&bar[XB_TMO])) break; if (sp > XB_SPIN_CAP) { atomicAdd(&bar[XB_TMO], 1u); break; } }
    }
    nloc = mine > 0u ? mine : 1u; nx = cnt > 0u ? cnt : 1u;
}
__device__ __forceinline__ void xcd_barrier_census(const XcdBarrier& b) {
    if (threadIdx.x == 0) { unsigned nloc, nx; xcd_barrier_complete(b.bar, b.x, nloc, nx); b.st[0] = nloc; b.st[1] = nx; }
    __syncthreads();
}
__device__ __forceinline__ void xcd_barrier(const XcdBarrier& b) {
    asm volatile("s_waitcnt vmcnt(0)" ::: "memory");
    __syncthreads();
    if (threadIdx.x == 0) {
        unsigned* bar = b.bar;
        __builtin_amdgcn_s_waitcnt(0);
        unsigned nloc = b.st[0], nx = b.st[1];
        if (nloc == 0u) { nloc = 1u; nx = 1u; }
        const unsigned old = xb_add(&bar[XB_XSUB(b.x)], 1u);
        const unsigned gen = old / nloc;
        if (old + 1u == (gen + 1u) * nloc) {
            __builtin_amdgcn_fence(__ATOMIC_RELEASE, "agent");
            asm volatile("s_waitcnt vmcnt(0)" ::: "memory");
            const unsigned og = xb_add(&bar[XB_TOP], 1u);
            const unsigned tg = og / nx;
            if (og + 1u == (tg + 1u) * nx) xb_add(&bar[XB_TOPGEN], 1u);
            else XB_SPIN(xb_ld(&bar[XB_TOPGEN]) == tg, bar);
            __builtin_amdgcn_fence(__ATOMIC_ACQUIRE, "agent");
            xb_add(&bar[XB_XGEN(b.x)], 1u);
            asm volatile("s_waitcnt vmcnt(0)" ::: "memory");
        } else {
            XB_SPIN(xb_ld(&bar[XB_XGEN(b.x)]) == gen, bar);
            __builtin_amdgcn_fence(__ATOMIC_ACQUIRE, "agent");
            asm volatile("s_waitcnt vmcnt(0)" ::: "memory");
        }
    }
    __syncthreads();
}

struct Args { const float* in[25]; float* out; unsigned char* ws; int ph_lo, ph_hi; };
enum { I_X = 0, I_C, I_CTX, I_CCTX, I_ADAW, I_ADAB, I_F1N, I_F1GU, I_F1D, I_MIXN, I_WIN, I_CONVW, I_QN, I_WQB, I_KVN, I_WKVB, I_SINK, I_WBC, I_WBM, I_WBG, I_WOUT, I_F2N, I_F2GU, I_F2D, I_FINN };

__device__ __forceinline__ int gqa_dim2phys(int d) { int i, n, p; if (d < 64) { i = d & 31; n = d >> 5; p = i; } else { i = (d - 64) & 31; n = (d - 64) >> 5; p = 32 + i; } const int wc = p >> 4, fq = (p >> 2) & 3, e = p & 3; return 32 * wc + 8 * fq + 4 * n + e; }
__device__ __forceinline__ int mla_dim2phys(int hh, int d) { int i, n, pp; if (d < 32) { i = d & 15; n = d >> 4; pp = i; } else { i = (d - 32) & 15; n = (d - 32) >> 4; pp = 16 + i; } const int p = 32 * hh + pp; const int wc = p >> 4, fq = (p >> 2) & 3, e = p & 3; return 32 * wc + 8 * fq + 4 * n + e; }
__device__ __forceinline__ int phys_row(int mode, int c) {
    if (mode == 0) return c;
    if (mode == 1) { return c < FF ? 256 * (c >> 7) + (c & 127) : 256 * ((c - FF) >> 7) + 128 + ((c - FF) & 127); }
    if (mode == 2) {
        if (c < OFF_GQA) return c;
        if (c < OFF_GATE) { const int j = c - OFF_GQA; if (j >= 1280) return 4096 + j; return 4096 + (j >> 7) * 128 + gqa_dim2phys(j & 127); }
        return 5632 + (c - OFF_GATE);
    }
    { const int h = c / 192, d = c - h * 192; if (d < 128) return h * 128 + d; return 1024 + (h >> 1) * 128 + mla_dim2phys(h & 1, d - 128); }
}
__device__ __forceinline__ void transpose_item(const float* __restrict__ W, int K, int N, bf16_t* __restrict__ WT, int mode, const float* __restrict__ kscale, LAS float* scr, int item, int lane) {
    const int nblk = N / 32, kb = item / nblk, nb = item - kb * nblk, k0 = 64 * kb, n0 = 32 * nb;
    float tv[32];
#pragma unroll
    for (int i = 0; i < 32; ++i) tv[i] = W[(size_t)(k0 + 2 * i + (lane >> 5)) * N + n0 + (lane & 31)];
#pragma unroll
    for (int i = 0; i < 32; ++i) { const int kk = 2 * i + (lane >> 5); float v = tv[i]; if (kscale) v *= kscale[k0 + kk]; scr[kk * 33 + (lane & 31)] = v; }
    LDS_WAIT(); asm volatile("" ::: "memory");
    const int c = lane & 7;
#pragma unroll
    for (int j = 0; j < 4; ++j) { const int n = (lane >> 3) + 8 * j; const LAS float* s = scr + (8 * c) * 33 + n;
        u32x4 o; o.x = pk2(s[0 * 33], s[1 * 33]); o.y = pk2(s[2 * 33], s[3 * 33]); o.z = pk2(s[4 * 33], s[5 * 33]); o.w = pk2(s[6 * 33], s[7 * 33]);
        *(u32x4*)(WT + (size_t)phys_row(mode, n0 + n) * K + k0 + 8 * c) = o; }
    LDS_WAIT(); asm volatile("" ::: "memory");
}


constexpr int PT_OFF = LDSCTL_OFF + 512;
__device__ __forceinline__ unsigned long long inaddr(unsigned pto, int k) {
    const unsigned long long v = *(const LAS unsigned long long*)(uintptr_t)(pto + 8u * (unsigned)k);
    const unsigned lo = __builtin_amdgcn_readfirstlane((unsigned)v), hi = __builtin_amdgcn_readfirstlane((unsigned)(v >> 32));
    return ((unsigned long long)hi << 32) | lo;
}
template <class T> __device__ __forceinline__ T* gptr(unsigned long long a) { return (T*)(GAS T*)a; }
__device__ __forceinline__ const float* inptr(unsigned pto, int k) { return gptr<const float>(inaddr(pto, k)); }
struct Frame {
    LAS unsigned char* lds; int tid, lane, wave, G, vcu;
};
__device__ __forceinline__ Frame fresh(const Frame& F0) { Frame F = F0; int t = threadIdx.x; asm volatile("" : "+v"(t)); F.tid = t; F.lane = t & 63; F.wave = __builtin_amdgcn_readfirstlane(t >> 6); return F; }

constexpr int CV_GU = (DM / 64) * (2 * FF / 32), CV_D = (FF / 64) * (DM / 32), CV_IN = (DM / 64) * (INC / 32), CV_QB = (512 / 64) * (1536 / 32), CV_KVB = (256 / 64) * (2048 / 32),
              CV_BR = (1024 / 64) * (DM / 32), CV_OUT = (DM / 64) * (DM / 32);
constexpr int CV_NITEMS = 2 * CV_GU + 2 * CV_D + CV_IN + CV_QB + CV_KVB + 3 * CV_BR + CV_OUT, CV_NTOT = CV_NITEMS + 192;
__device__ __forceinline__ void convert_item(unsigned pto, unsigned char* wsb, int l, LAS float* scr, int it, int lane) {
    if (it >= CV_NITEMS) {
        unsigned zz = 0u; asm volatile("" : "+v"(zz));
        u32x4* z = (u32x4*)(wsb + W_IN + (size_t)(OFF_MLA + 832 + (it - CV_NITEMS)) * DM * 2);
#pragma unroll
        for (int i = 0; i < 4; ++i) z[lane + 64 * i] = (u32x4){zz, zz, zz, zz};
        return;
    }
    int r = it, idx = I_F1GU, K = DM, N = 2 * FF, mode = 1, ksi = -1; size_t lstr = (size_t)DM * 2 * FF, woff = W_GU1; bool hit = false;
#define CV_CASE(cnt, idx_, lstr_, K_, N_, woff_, mode_, ksi_) if (!hit) { if (r < (cnt)) { hit = true; idx = (idx_); lstr = (lstr_); K = (K_); N = (N_); woff = (woff_); mode = (mode_); ksi = (ksi_); } else r -= (cnt); }
    CV_CASE(CV_GU, I_F1GU, (size_t)DM * 2 * FF, DM, 2 * FF, W_GU1, 1, -1)
    CV_CASE(CV_GU, I_F2GU, (size_t)DM * 2 * FF, DM, 2 * FF, W_GU2, 1, -1)
    CV_CASE(CV_D, I_F1D, (size_t)FF * DM, FF, DM, W_D1, 0, -1)
    CV_CASE(CV_D, I_F2D, (size_t)FF * DM, FF, DM, W_D2, 0, -1)
    CV_CASE(CV_IN, I_WIN, (size_t)DM * INC, DM, INC, W_IN, 2, -1)
    CV_CASE(CV_QB, I_WQB, (size_t)512 * 1536, 512, 1536, W_QB, 3, I_QN)
    CV_CASE(CV_KVB, I_WKVB, (size_t)256 * 2048, 256, 2048, W_KVB, 0, I_KVN)
    CV_CASE(CV_BR, I_WBC, (size_t)1024 * DM, 1024, DM, W_BR, 0, -1)
    CV_CASE(CV_BR, I_WBM, (size_t)1024 * DM, 1024, DM, W_BR + 4 * MiB, 0, -1)
    CV_CASE(CV_BR, I_WBG, (size_t)1024 * DM, 1024, DM, W_BR + 8 * MiB, 0, -1)
    CV_CASE(CV_OUT, I_WOUT, (size_t)DM * DM, DM, DM, W_OUT, 0, -1)
#undef CV_CASE
    const float* ks = ksi >= 0 ? inptr(pto, ksi) + l * K : nullptr;
    transpose_item(inptr(pto, idx) + (size_t)l * lstr, K, N, (bf16_t*)(wsb + woff), mode, ks, scr, r, lane);
}
__device__ __forceinline__ void convert_weights(const Frame& F0, unsigned pto, unsigned char* ws, int l) {
    const Frame F = fresh(F0);
    LAS float* scr = (LAS float*)(F.lds + F.wave * 16384);
    const int gw = F.vcu * NWAVES + F.wave, NGW = F.G * NWAVES;
    for (int it = gw; it < CV_NTOT; it += NGW) convert_item(pto, ws, l, scr, it, F.lane);
}
constexpr int CV_BATCH = 16;
__device__ __forceinline__ bool fill_step(volatile LAS unsigned* st, int wave, int lane, GAS unsigned* ctr, unsigned pto, unsigned char* ws, LAS float* scr) {
    unsigned cur = (unsigned)__builtin_amdgcn_readfirstlane((int)st[8 + 2 * wave]), end = (unsigned)__builtin_amdgcn_readfirstlane((int)st[9 + 2 * wave]);
    if (cur == end) {
        if ((unsigned)__builtin_amdgcn_readfirstlane((int)__hip_atomic_load(ctr, __ATOMIC_RELAXED, __HIP_MEMORY_SCOPE_AGENT)) * (unsigned)CV_BATCH >= (unsigned)CV_NTOT) return false;
        unsigned tk = 0u; if (lane == 0) tk = __hip_atomic_fetch_add(ctr, 1u, __ATOMIC_RELAXED, __HIP_MEMORY_SCOPE_AGENT);
        tk = (unsigned)__builtin_amdgcn_readfirstlane((int)tk);
        cur = tk * CV_BATCH; end = cur + CV_BATCH;
        if (cur >= (unsigned)CV_NTOT) return false;
        if (end > (unsigned)CV_NTOT) end = (unsigned)CV_NTOT;
    }
    convert_item(pto, ws + W2_SHIFT, 1, scr, (int)cur, lane);
    if (lane == 0) { st[8 + 2 * wave] = cur + 1u; st[9 + 2 * wave] = end; }
    return true;
}
__device__ __forceinline__ void convert_finish(const Frame& F0, unsigned pto, unsigned char* ws, GAS unsigned* ctr, volatile LAS unsigned* st) {
    const Frame F = fresh(F0);
    LAS float* scr = (LAS float*)(F.lds + F.wave * 16384);
    while (fill_step(st, F.wave, F.lane, ctr, pto, ws, scr)) {}
}


__device__ __forceinline__ void slack_fill(const Frame& F0, unsigned pto, unsigned char* ws, GAS unsigned* ctr, volatile LAS unsigned* st, int n) {
    const Frame F = fresh(F0);
    LAS float* scr = (LAS float*)(F.lds + F.wave * 16384);
    for (int k = 0; k < n; ++k) if (!fill_step(st, F.wave, F.lane, ctr, pto, ws, scr)) break;
}

__device__ __forceinline__ void mod_gemv(const Frame& F0, unsigned pto, unsigned char* ws) {
    const Frame F = fresh(F0);
    LAS float* sv = (LAS float*)F.lds;
    LAS float* red = (LAS float*)(F.lds + 40960);
    for (int i = F.tid; i < 5 * DM; i += NWAVES * 64) { const int r = i >> 11, k = i & 2047; const float x = r < 4 ? inptr(pto, I_C)[r * DM + k] : inptr(pto, I_CCTX)[k]; sv[i] = silu_f(x); }
    __syncthreads();
    float* MOD = (float*)(ws + WS_MOD);
    const int half = F.lane >> 5, cl = F.lane & 31;
    for (int unit = blockIdx.x; unit < 2 * 144; unit += F.G) {
        const int l = unit / 144, cb = unit - l * 144;
        const float* wp = inptr(pto, I_ADAW) + ((size_t)l * DM + F.wave * 256 + half) * MODW + cb * 128 + cl * 4;
        f32x4 acc[5];
#pragma unroll
        for (int r = 0; r < 5; ++r) acc[r] = (f32x4){0.f, 0.f, 0.f, 0.f};
#pragma unroll 8
        for (int it = 0; it < 128; ++it) { const f32x4 w = *(const f32x4*)(wp + (size_t)it * 2 * MODW); const int k = F.wave * 256 + it * 2 + half;
#pragma unroll
            for (int r = 0; r < 5; ++r) acc[r] += w * sv[r * DM + k]; }
#pragma unroll
        for (int r = 0; r < 5; ++r) *(LAS f32x4*)(red + ((F.wave * 2 + half) * 5 + r) * 128 + cl * 4) = acc[r];
        __syncthreads();
        for (int o = F.tid; o < 640; o += NWAVES * 64) { const int r = o >> 7, cc = o & 127; float s = 0.f;
#pragma unroll
            for (int p = 0; p < 16; ++p) s += red[(p * 5 + r) * 128 + cc];
            MOD[((size_t)l * 5 + r) * MODW + cb * 128 + cc] = s + inptr(pto, I_ADAB)[(size_t)l * MODW + cb * 128 + cc]; }
        __syncthreads();
    }
}
__device__ __forceinline__ void rope_tables(const Frame& F0, unsigned char* ws) {
    const Frame F = fresh(F0);
    if (blockIdx.x != 0) return;
    float* c64 = (float*)(ws + WS_ROPE); float* s64 = c64 + 2048; float* c32 = s64 + 2048; float* s32 = c32 + 1024;
    for (int i = F.tid; i < 2048; i += NWAVES * 64) { const int pos = i >> 5, f = i & 31; const float inv = __builtin_amdgcn_exp2f(-(float)f * (13.287712379549449f / 32.0f)); const float ang = (float)pos * inv;
        c64[i] = cosf(ang); s64[i] = sinf(ang); }
    for (int i = F.tid; i < 1024; i += NWAVES * 64) { const int pos = i >> 4, f = i & 15; const float inv = __builtin_amdgcn_exp2f(-(float)f * (13.287712379549449f / 16.0f)); const float ang = (float)pos * inv;
        c32[i] = cosf(ang); s32[i] = sinf(ang); }
}

__device__ __forceinline__ void norm_phase(const Frame& F0, const float* src_lat, const float* src_ctx, const float* gain, const float* modl, int ishift, int iscale, bf16_t* XN, int nrows,
                                           const float* part, const float* fgate, float fcoef, float* hctx_out) {
    const Frame F = fresh(F0);
    const int gw = F.vcu * NWAVES + F.wave, NGW = F.G * NWAVES;
    for (int row = gw; row < nrows; row += NGW) {
        const float* src = row < TL ? src_lat + (size_t)row * DM : src_ctx + (size_t)(row - TL) * DM;
        const int mrow = row < TL ? (row >> 12) : 4;
        const float* sh = modl + (size_t)mrow * MODW + ishift * DM; const float* sc = modl + (size_t)mrow * MODW + iscale * DM;
        f32x4 v[8]; float ss = 0.f;
        if (part != nullptr && row >= TL) {
            const float* pr = part + (size_t)(row - TL) * DM;
#pragma unroll
            for (int j = 0; j < 8; ++j) { const int c = 256 * j + 4 * F.lane;
                const f32x4 p = (*(const f32x4*)(pr + c) + *(const f32x4*)(pr + (size_t)TC * DM + c)) + (*(const f32x4*)(pr + (size_t)2 * TC * DM + c) + *(const f32x4*)(pr + (size_t)3 * TC * DM + c));
                v[j] = *(const f32x4*)(src + c) + (*(const f32x4*)(fgate + c) * fcoef) * p;
                *(f32x4*)(hctx_out + (size_t)(row - TL) * DM + c) = v[j];
                ss += (v[j][0] * v[j][0] + v[j][1] * v[j][1]) + (v[j][2] * v[j][2] + v[j][3] * v[j][3]); }
        } else {
#pragma unroll
        for (int j = 0; j < 8; ++j) { v[j] = *(const f32x4*)(src + 256 * j + 4 * F.lane); ss += (v[j][0] * v[j][0] + v[j][1] * v[j][1]) + (v[j][2] * v[j][2] + v[j][3] * v[j][3]); }
        }
        const float r = 1.0f / sqrtf(wave_sum(ss, F.lane) * (1.0f / DM) + EPS);
#pragma unroll
        for (int j = 0; j < 8; ++j) { const int c = 256 * j + 4 * F.lane; const f32x4 g = *(const f32x4*)(gain + c), s1 = *(const f32x4*)(sc + c), s0 = *(const f32x4*)(sh + c);
            const f32x4 y = (v[j] * r) * g * (s1 + 1.0f) + s0;
            u32x2 w; w.x = pk2(y[0], y[1]); w.y = pk2(y[2], y[3]); *(u32x2*)(XN + (size_t)row * DM + c) = w; }
    }
}
__device__ __forceinline__ void final_norm(const Frame& F0, const float* H, const float* gain, float* out) {
    const Frame F = fresh(F0);
    const int gw = F.vcu * NWAVES + F.wave, NGW = F.G * NWAVES;
    for (int row = gw; row < TL; row += NGW) {
        const float* src = H + (size_t)row * DM; f32x4 v[8]; float ss = 0.f;
#pragma unroll
        for (int j = 0; j < 8; ++j) { v[j] = *(const f32x4*)(src + 256 * j + 4 * F.lane); ss += (v[j][0] * v[j][0] + v[j][1] * v[j][1]) + (v[j][2] * v[j][2] + v[j][3] * v[j][3]); }
        const float r = 1.0f / sqrtf(wave_sum(ss, F.lane) * (1.0f / DM) + EPS);
#pragma unroll
        for (int j = 0; j < 8; ++j) { const int c = 256 * j + 4 * F.lane; const f32x4 g = *(const f32x4*)(gain + c); *(f32x4*)(out + (size_t)row * DM + c) = (v[j] * r) * g; }
    }
}
__device__ __forceinline__ void conv_phase(const Frame& F0, bf16_t* P, const float* cw, int nrows) {
    const Frame F = fresh(F0);
    const int gw = F.vcu * NWAVES + F.wave, NGW = F.G * NWAVES;
    for (int item = gw; item < nrows * 2; item += NGW) {
        const int row = item >> 1, ch0 = (item & 1) * 512 + F.lane * 8;
        bool first, last; if (row < TL) { const int t = row & (SEQ - 1); first = t == 0; last = t == SEQ - 1; } else { const int t = (row - TL) & (CTXL - 1); first = t == 0; last = t == CTXL - 1; }
        const bf16_t* rp = P + (size_t)row * 3072 + ch0;
        const u32x4 gb = *(const u32x4*)rp, gc0 = *(const u32x4*)(rp + 1024), v0 = *(const u32x4*)(rp + 2048);
        u32x4 gcm = (u32x4){0u, 0u, 0u, 0u}, vm = gcm, gcp = gcm, vp = gcm;
        if (!first) { gcm = *(const u32x4*)(rp - 3072 + 1024); vm = *(const u32x4*)(rp - 3072 + 2048); }
        if (!last) { gcp = *(const u32x4*)(rp + 3072 + 1024); vp = *(const u32x4*)(rp + 3072 + 2048); }
        const f32x4 w0a = *(const f32x4*)(cw + ch0), w0b = *(const f32x4*)(cw + ch0 + 4), w1a = *(const f32x4*)(cw + 1024 + ch0), w1b = *(const f32x4*)(cw + 1024 + ch0 + 4),
                    w2a = *(const f32x4*)(cw + 2048 + ch0), w2b = *(const f32x4*)(cw + 2048 + ch0 + 4);
        u32x4 o;
#pragma unroll
        for (int q = 0; q < 4; ++q) {
            const float wl0 = q < 2 ? w0a[2 * q] : w0b[2 * q - 4], wh0 = q < 2 ? w0a[2 * q + 1] : w0b[2 * q - 3];
            const float wl1 = q < 2 ? w1a[2 * q] : w1b[2 * q - 4], wh1 = q < 2 ? w1a[2 * q + 1] : w1b[2 * q - 3];
            const float wl2 = q < 2 ? w2a[2 * q] : w2b[2 * q - 4], wh2 = q < 2 ? w2a[2 * q + 1] : w2b[2 * q - 3];
            const float lo = bflo(gb[q]) * (wl0 * bflo(gcm[q]) * bflo(vm[q]) + wl1 * bflo(gc0[q]) * bflo(v0[q]) + wl2 * bflo(gcp[q]) * bflo(vp[q]));
            const float hi = bfhi(gb[q]) * (wh0 * bfhi(gcm[q]) * bfhi(vm[q]) + wh1 * bfhi(gc0[q]) * bfhi(v0[q]) + wh2 * bfhi(gcp[q]) * bfhi(vp[q]));
            o[q] = pk2(lo, hi);
        }
        *(u32x4*)(P + (size_t)row * 3072 + ch0) = o;
    }
}
__device__ __forceinline__ void krope_phase(const Frame& F0, const bf16_t* PMLA, bf16_t* KM, const float* cos32, const float* sin32) {
    const Frame F = fresh(F0);
    const int gw = F.vcu * NWAVES + F.wave, NGW = F.G * NWAVES; const int d = F.lane;
    for (int row = gw; row < TT; row += NGW) {
        const float x = bf2f(PMLA[(size_t)row * 1024 + 768 + d]); const float y = shflx(x, 16, d);
        float o = x;
        if (row < TL) { const int t = row & (SEQ - 1); const int pos = d < 32 ? (t >> 6) : (t & 63); const float c = cos32[pos * 16 + (d & 15)], s = sin32[pos * 16 + (d & 15)];
            o = (d & 16) ? (y * s + x * c) : (x * c - y * s); }
        const bf16_t ob = (bf16_t)f2bf(o);
#pragma unroll
        for (int h = 0; h < 8; ++h) KM[(size_t)row * 1536 + h * 192 + 128 + d] = ob;
    }
}

__global__ void __launch_bounds__(NWAVES * 64, 2) hybrid_fwd(Args args) {
    extern __shared__ __attribute__((aligned(16))) unsigned char lds_raw[];
    Frame F; F.lds = (LAS unsigned char*)lds_raw; F.tid = threadIdx.x; F.lane = F.tid & 63; F.wave = __builtin_amdgcn_readfirstlane(F.tid >> 6);
    F.G = gridDim.x; { const int bx = blockIdx.x; F.vcu = (F.G % 8 == 0) ? (bx % 8) * (F.G / 8) + bx / 8 : bx; }
    unsigned char* ws = args.ws;
    unsigned* ctl = (unsigned*)(ws + WS_CTL);
    volatile LAS unsigned* MISC = (volatile LAS unsigned*)(F.lds + MISC_OFF);
    for (int u = F.tid; u < (LDS_BYTES - LDSCTL_OFF) / 4; u += NWAVES * 64) ((LAS unsigned*)(F.lds + LDSCTL_OFF))[u] = 0u;
    __syncthreads();
    if (F.tid < 25) ((LAS unsigned long long*)(F.lds + PT_OFF))[F.tid] = (unsigned long long)args.in[F.tid];
    if (F.tid == 25) ((LAS unsigned long long*)(F.lds + PT_OFF))[25] = (unsigned long long)args.out;
    __syncthreads();
    const int lo = args.ph_lo, hi = args.ph_hi;
    const bool multi = (hi - lo) > 1;
    XcdBarrier bar; bar.bar = ctl + CW_BAR; bar.x = 0; bar.st = nullptr;
    if (multi) bar = xcd_barrier_post(ctl + CW_BAR, MISC + 8);
#ifndef PHT_MASK
#define PHT_MASK 0x7fff
#endif
#define PHT(j) ((PHT_MASK >> (j)) & 1)
#ifndef DUP_MASK
#define DUP_MASK 0
#endif
#define NREP(j) (((DUP_MASK >> (j)) & 1) ? 2 : 1)
#define IN(k) (lo <= (k) && (k) < hi)
#define SEAM(k) do { if (IN(k) && IN((k) + 1)) xcd_barrier(bar); } while (0)
#define PH_BEGIN GAS unsigned char* wsg = (GAS unsigned char*)ws; asm volatile("" : "+s"(wsg)); unsigned pto = PT_OFF; asm volatile("" : "+s"(pto)); const int bx = (int)blockIdx.x; (void)bx; (void)pto; unsigned char* wsp = (unsigned char*)wsg; (void)wsp;
#define WSP(T, off) ((T*)(GAS T*)(wsg + (off)))
#define MODL (WSP(const float, WS_MOD) + (size_t)l * 5 * MODW)
#define COS64 WSP(const float, WS_ROPE)
#define SIN64 (WSP(const float, WS_ROPE) + 2048)
#define COS32 (WSP(const float, WS_ROPE) + 4096)
#define SIN32 (WSP(const float, WS_ROPE) + 5120)
#define WL(off) ((off) + (l ? W2_SHIFT : (size_t)0))
#define FILLCTR ((GAS unsigned*)(wsg + WS_CTL) + CW_FILL)
#ifndef SLACK_GU
#define SLACK_GU 10
#endif
#ifndef SLACK_WIN
#define SLACK_WIN 12
#endif
#ifndef SLACK_MERGE
#define SLACK_MERGE 18
#endif
#define HLAT WSP(float, WS_H)
#define HCTX (WSP(float, WS_H) + (size_t)TL * DM)

    if (PHT(13) && IN(0)) { PH_BEGIN mod_gemv(F, pto, wsp); rope_tables(F, wsp); for (int rep = 0; rep < NREP(13); ++rep) convert_weights(F, pto, wsp, 0); }
    if (multi) xcd_barrier_census(bar);
    SEAM(0);

    for (int l = 0; l < 2; ++l) {
        const int pb = 1 + 13 * l;
        const int nM2 = l == 0 ? TT / 256 : TL / 256;

        if (PHT(0) && IN(pb + 0)) for (int rep = 0; rep < NREP(0); ++rep) { PH_BEGIN
            norm_phase(F, gptr<const float>(l == 0 ? inaddr(pto, I_X) : (unsigned long long)(wsg + WS_H)), gptr<const float>(l == 0 ? inaddr(pto, I_CTX) : (unsigned long long)(wsg + WS_H + (size_t)TL * DM * 4)), inptr(pto, I_F1N) + l * DM, MODL, 0, 1, WSP(bf16_t, WS_XN), TT,
                       gptr<const float>(l == 0 ? 0ull : (unsigned long long)(wsg + WS_PART)), WSP(const float, WS_MOD) + 4 * MODW + 8 * DM, 0.5f, HCTX); }
        SEAM(pb + 0);
        if (PHT(1) && IN(pb + 1)) for (int rep = 0; rep < NREP(1); ++rep) { PH_BEGIN
            pg8::Gemm g{WSP(bf16_t, WS_XN), WSP(const bf16_t, WL(W_GU1)), DM, DM, DM, 0, 0}; pg8::StaticOrder S; S.init(TT / 256, 2 * FF / 256, F.G, bx, DM);
            pg8::EpiSwiGLU E{WSP(bf16_t, WS_BIG)}; pg8::gemm_phase<pg8::EpiSwiGLU, pg8::StaticOrder, true>(F.lds, g, S, E);
            if (l == 0 && SLACK_GU > 0 && bx >= (TT / 256) * (2 * FF / 256) % F.G && (TT / 256) * (2 * FF / 256) % F.G != 0) slack_fill(F, pto, wsp, FILLCTR, MISC + 8, SLACK_GU); }
        SEAM(pb + 1);
        if (PHT(2) && IN(pb + 2)) { PH_BEGIN
            pg8::Gemm g{WSP(bf16_t, WS_BIG), WSP(const bf16_t, WL(W_D1)), FF, FF, FF, 0, 0}; pg8::SplitOrder S; S.init(64, DM / 256, F.G, bx, FF); S.ks = 4;
            pg8::EpiResid E{gptr<const float>(l == 0 ? inaddr(pto, I_X) : (unsigned long long)(wsg + WS_H)), nullptr, HLAT, MODL, 2, 0.5f, WSP(float, WS_PART)}; pg8::gemm_phase<pg8::EpiResid, pg8::SplitOrder, true>(F.lds, g, S, E); }
        SEAM(pb + 2);
        if (PHT(3) && IN(pb + 3)) { PH_BEGIN norm_phase(F, HLAT, gptr<const float>(l == 0 ? inaddr(pto, I_CTX) : (unsigned long long)(wsg + WS_H + (size_t)TL * DM * 4)), inptr(pto, I_MIXN) + l * DM, MODL, 3, 4, WSP(bf16_t, WS_XN), TT,
                       WSP(const float, WS_PART), MODL + 4 * MODW + 2 * DM, 0.5f, HCTX); }
        SEAM(pb + 3);
        if (PHT(4) && IN(pb + 4)) for (int rep = 0; rep < NREP(4); ++rep) { PH_BEGIN
            pg8::Gemm g{WSP(bf16_t, WS_XN), WSP(const bf16_t, WL(W_IN)), DM, DM, DM, 0, 0}; pg8::WinOrder S; S.init(l == 0 ? TT / 256 : TL / 256, INP / 256, F.G, bx, DM); S.trim = (l != 0);
            pg8::EpiWin E{WSP(bf16_t, WS_PCONV), WSP(bf16_t, WS_PMLA), WSP(bf16_t, WS_PGQA), WSP(bf16_t, WS_PGATE), WSP(float, WS_SSQ), COS64, SIN64};
            pg8::gemm_phase<pg8::EpiWin, pg8::WinOrder, true>(F.lds, g, S, E);
            if (l == 0 && SLACK_WIN > 0 && bx >= (TT / 256) * (INP / 256) % F.G && (TT / 256) * (INP / 256) % F.G != 0) slack_fill(F, pto, wsp, FILLCTR, MISC + 8, SLACK_WIN); }
        SEAM(pb + 4);
        if (PHT(5) && IN(pb + 5)) {
            { PH_BEGIN pg8::Gemm g{WSP(bf16_t, WS_PMLA), WSP(const bf16_t, WL(W_QB)), 1024, 512, 512, 0, 0}; pg8::StaticOrder S; S.init(nM2, 1536 / 256, F.G, bx, 512);
              pg8::EpiMlaQ E{WSP(bf16_t, WS_QMLA), WSP(const float, WS_SSQ), COS32, SIN32}; pg8::gemm_phase<pg8::EpiMlaQ, pg8::StaticOrder, true>(F.lds, g, S, E); }
            { PH_BEGIN pg8::Gemm g{WSP(bf16_t, WS_PMLA) + 512, WSP(const bf16_t, WL(W_KVB)), 1024, 256, 256, 0, 0}; pg8::StaticOrder S; S.init(TT / 256, 2048 / 256, F.G, bx, 256);
              pg8::EpiMlaKV E{WSP(bf16_t, WS_KMLA), WSP(bf16_t, WS_VMLA), WSP(const float, WS_SSQ)}; pg8::gemm_phase<pg8::EpiMlaKV, pg8::StaticOrder, true>(F.lds, g, S, E); }
            { PH_BEGIN krope_phase(F, WSP(const bf16_t, WS_PMLA), WSP(bf16_t, WS_KMLA), COS32, SIN32);
              conv_phase(F, WSP(bf16_t, WS_PCONV), inptr(pto, I_CONVW) + l * 3 * 1024, nM2 * 256); }
        }
        SEAM(pb + 5);
        if (PHT(6) && IN(pb + 6)) for (int rep = 0; rep < NREP(6); ++rep) { PH_BEGIN
            const int nU = l == 0 ? 1088 : 1024;
            bf16_t* QMLA = WSP(bf16_t, WS_QMLA); bf16_t* KMLA = WSP(bf16_t, WS_KMLA); bf16_t* VMLA = WSP(bf16_t, WS_VMLA); bf16_t* PGQA = WSP(bf16_t, WS_PGQA); bf16_t* PCONV = WSP(bf16_t, WS_PCONV);
            const float* sinkp = inptr(pto, I_SINK) + l * 8;
            for (int uix = F.vcu; uix < nU; uix += F.G) {
                if (uix < 512) {
                    const int bh = uix >> 4, qb = uix & 15, b = bh >> 3, h = bh & 7; const long q0 = (long)b * SEQ + qb * 256;
                    att::attn_unit<192, 1536, 1536, 1024, 3072, false, false>(QMLA + q0 * 1536 + h * 192, KMLA + h * 192, VMLA + h * 128, PCONV + q0 * 3072 + 1024 + h * 128,
                        b * SEQ, 64, TL + b * CTXL, 68, 0, 0, 0.f, (char*)lds_raw);
                } else if (uix < 1024) {
                    const int v = uix - 512, bh = v >> 4, qb = v & 15, b = bh >> 3, h = bh & 7, kvh = h >> 2; const long q0 = (long)b * SEQ + qb * 256;
                    const int i0 = qb * 256, klo = i0 >= 128 ? i0 - 128 : 0, khi = i0 + 384 <= SEQ ? i0 + 384 : SEQ;
                    att::attn_unit<128, 1536, 1536, 1536, 3072, true, true>(PGQA + q0 * 1536 + h * 128, PGQA + 1024 + kvh * 128, PGQA + 1280 + kvh * 128, PCONV + q0 * 3072 + 2048 + h * 128,
                        TL + b * CTXL, 4, b * SEQ + klo, 4 + (khi - klo) / 64, i0, klo, sinkp[h] * LOG2E, (char*)lds_raw);
                } else if (uix < 1056) {
                    const int v = uix - 1024, b = v >> 3, h = v & 7; const long q0 = TL + (long)b * CTXL;
                    att::attn_unit<192, 1536, 1536, 1024, 3072, false, false>(QMLA + q0 * 1536 + h * 192, KMLA + h * 192, VMLA + h * 128, PCONV + q0 * 3072 + 1024 + h * 128,
                        TL + b * CTXL, 4, 0, 4, 0, 0, 0.f, (char*)lds_raw);
                } else {
                    const int v = uix - 1056, b = v >> 3, h = v & 7, kvh = h >> 2; const long q0 = TL + (long)b * CTXL;
                    att::attn_unit<128, 1536, 1536, 1536, 3072, false, true>(PGQA + q0 * 1536 + h * 128, PGQA + 1024 + kvh * 128, PGQA + 1280 + kvh * 128, PCONV + q0 * 3072 + 2048 + h * 128,
                        TL + b * CTXL, 4, 0, 4, 0, 0, sinkp[h] * LOG2E, (char*)lds_raw);
                }
            }
        }
        SEAM(pb + 6);
        if (PHT(7) && IN(pb + 7)) for (int rep = 0; rep < NREP(7); ++rep) { PH_BEGIN
            pg8::Gemm g{WSP(bf16_t, WS_PCONV), WSP(const bf16_t, WL(W_BR)), 3072, 1024, 1024, 2048, 4 * MiB}; pg8::MergeOrder S; S.init(nM2, DM / 256, F.G, bx, 1024);
            pg8::EpiMerge E{WSP(const bf16_t, WS_PGATE), WSP(bf16_t, WS_XN)}; pg8::gemm_phase<pg8::EpiMerge, pg8::MergeOrder, true>(F.lds, g, S, E);
            if (l == 0 && SLACK_MERGE > 0 && bx >= (TT / 256) * (DM / 256) % F.G && (TT / 256) * (DM / 256) % F.G != 0) slack_fill(F, pto, wsp, FILLCTR, MISC + 8, SLACK_MERGE); }
        SEAM(pb + 7);
        if (PHT(8) && IN(pb + 8)) { PH_BEGIN
            pg8::Gemm g{WSP(bf16_t, WS_XN), WSP(const bf16_t, WL(W_OUT)), DM, DM, DM, 0, 0}; pg8::SplitOrder S; S.init(64, DM / 256, F.G, bx, DM); S.ks = l == 0 ? 4 : 0;
            pg8::EpiResid E{HLAT, nullptr, HLAT, MODL, 5, 1.0f, gptr<float>(l == 0 ? (unsigned long long)(wsg + WS_PART) : 0ull)}; pg8::gemm_phase<pg8::EpiResid, pg8::SplitOrder, true>(F.lds, g, S, E); }
        SEAM(pb + 8);
        if (PHT(9) && IN(pb + 9)) { PH_BEGIN norm_phase(F, HLAT, HCTX, inptr(pto, I_F2N) + l * DM, MODL, 6, 7, WSP(bf16_t, WS_XN), nM2 * 256,
                       gptr<const float>(l == 0 ? (unsigned long long)(wsg + WS_PART) : 0ull), MODL + 4 * MODW + 5 * DM, 1.0f, HCTX); }
        SEAM(pb + 9);
        if (PHT(10) && IN(pb + 10)) { PH_BEGIN
            pg8::Gemm g{WSP(bf16_t, WS_XN), WSP(const bf16_t, WL(W_GU2)), DM, DM, DM, 0, 0}; pg8::StaticOrder S; S.init(nM2, 2 * FF / 256, F.G, bx, DM);
            pg8::EpiSwiGLU E{WSP(bf16_t, WS_BIG)}; pg8::gemm_phase<pg8::EpiSwiGLU, pg8::StaticOrder, true>(F.lds, g, S, E);
            if (l == 0 && SLACK_GU > 0 && bx >= nM2 * (2 * FF / 256) % F.G && nM2 * (2 * FF / 256) % F.G != 0) slack_fill(F, pto, wsp, FILLCTR, MISC + 8, SLACK_GU); }
        SEAM(pb + 10);
        if (PHT(11) && IN(pb + 11)) { PH_BEGIN
            pg8::Gemm g{WSP(bf16_t, WS_BIG), WSP(const bf16_t, WL(W_D2)), FF, FF, FF, 0, 0}; pg8::SplitOrder S; S.init(64, DM / 256, F.G, bx, FF); S.ks = l == 0 ? 4 : 0;
            pg8::EpiResid E{HLAT, nullptr, HLAT, MODL, 8, 0.5f, gptr<float>(l == 0 ? (unsigned long long)(wsg + WS_PART) : 0ull)}; pg8::gemm_phase<pg8::EpiResid, pg8::SplitOrder, true>(F.lds, g, S, E); }
        SEAM(pb + 11);
        if (PHT(12) && IN(pb + 12)) { if (l == 0) { PH_BEGIN convert_finish(F, pto, wsp, FILLCTR, MISC + 8); } }
        SEAM(pb + 12);
    }
    if (PHT(14) && IN(27)) { PH_BEGIN final_norm(F, HLAT, inptr(pto, I_FINN), gptr<float>(inaddr(pto, 25))); }
#undef IN
#undef SEAM
}

constexpr int N_PHASES = 28;
extern "C" void kernel_launch(void* const* d_in, const int* in_sizes, int n_in, void* d_out, int out_size, void* d_ws, size_t ws_size, hipStream_t stream) {
    static int grid = 0;
    if (grid == 0) {
        if (n_in != 25 || in_sizes[0] != TL * DM || out_size != TL * DM || ws_size < WS_END) {
            fprintf(stderr, "kernel_launch: shape mismatch n_in %d in0 %d out %d ws %zu (need %zu)\n", n_in, n_in > 0 ? in_sizes[0] : -1, out_size, ws_size, (size_t)WS_END); grid = -1; return; }
        int dev = 0, cus = 0;
        if (hipGetDevice(&dev) != hipSuccess || hipDeviceGetAttribute(&cus, hipDeviceAttributeMultiprocessorCount, dev) != hipSuccess) { grid = -1; return; }
        if (hipFuncSetAttribute((const void*)hybrid_fwd, hipFuncAttributeMaxDynamicSharedMemorySize, LDS_BYTES) != hipSuccess) { fprintf(stderr, "kernel_launch: hipFuncSetAttribute failed\n"); grid = -1; return; }
        (void)hipGetLastError();
        grid = cus;
    }
    if (grid < 0) return;
    (void)hipMemsetAsync((char*)d_ws + WS_CTL, 0, CTL_ZERO_BYTES, stream);
    Args a{};
    for (int i = 0; i < 25; ++i) a.in[i] = (const float*)d_in[i];
    a.out = (float*)d_out; a.ws = (unsigned char*)d_ws;
#if MK_ONE_LAUNCH
    a.ph_lo = 0; a.ph_hi = N_PHASES;
    hipLaunchKernelGGL(hybrid_fwd, dim3(grid), dim3(NWAVES * 64), LDS_BYTES, stream, a);
#else
    for (int k = 0; k < N_PHASES; ++k) {
        if (k == 26) continue;
        a.ph_lo = k; a.ph_hi = k + 1;
        hipLaunchKernelGGL(hybrid_fwd, dim3(grid), dim3(NWAVES * 64), LDS_BYTES, stream, a);
    }
#endif
    const hipError_t le = hipPeekAtLastError();
    if (le != hipSuccess) fprintf(stderr, "kernel_launch: launch failed: %s\n", hipGetErrorName(le));
}
```

```cpp
#include <hip/hip_runtime.h>
#include <cstdio>
#include <cstdint>

#ifndef MK_ONE_LAUNCH
#define MK_ONE_LAUNCH 1
#endif

#define LAS __attribute__((address_space(3)))
#define GAS __attribute__((address_space(1)))
typedef unsigned short bf16_t;
typedef short bf16x8 __attribute__((ext_vector_type(8)));
typedef short s16x4 __attribute__((ext_vector_type(4)));
typedef float f32x4 __attribute__((ext_vector_type(4)));
typedef float f32x2 __attribute__((ext_vector_type(2)));
typedef float f32x16 __attribute__((ext_vector_type(16)));
typedef unsigned u32x4 __attribute__((ext_vector_type(4)));
typedef unsigned u32x2 __attribute__((ext_vector_type(2)));

constexpr int DM = 2048, NBATCH = 4, SEQ = 4096, TL = NBATCH * SEQ, CTXL = 256, TC = NBATCH * CTXL, TT = TL + TC;
constexpr int FF = 5632, NMOD = 9, MODW = NMOD * DM;
constexpr int INC = 11584, INP = 11776;
constexpr int OFF_MLA = 3072, OFF_GQA = 3904, OFF_GATE = 5440;
constexpr float EPS = 1e-6f;
constexpr float LOG2E = 1.4426950408889634f;

constexpr size_t MiB = 1u << 20;
constexpr size_t WS_CTL = 0, CTL_ZERO_BYTES = 64 * 1024;
constexpr size_t WS_MOD = 1 * MiB;
constexpr size_t WS_ROPE = WS_MOD + 768 * 1024;
constexpr size_t WS_SSQ = 2 * MiB;
constexpr size_t WS_W = 4 * MiB;
constexpr size_t W_GU1 = WS_W, W_D1 = W_GU1 + 44 * MiB, W_IN = W_D1 + 22 * MiB, W_QB = W_IN + 46 * MiB, W_KVB = W_QB + 2 * MiB,
                 W_BR = W_KVB + 2 * MiB, W_OUT = W_BR + 12 * MiB, W_GU2 = W_OUT + 8 * MiB, W_D2 = W_GU2 + 44 * MiB, W_END = W_D2 + 22 * MiB;
constexpr size_t WS_H = 208 * MiB;
constexpr size_t WS_XN = WS_H + 136 * MiB;
constexpr size_t WS_BIG = WS_XN + 68 * MiB;
constexpr size_t WS_PCONV = WS_BIG, WS_PMLA = WS_PCONV + 102 * MiB, WS_PGQA = WS_PMLA + 34 * MiB, WS_PGATE = WS_PGQA + 51 * MiB;
constexpr size_t WS_QMLA = WS_PGATE + 204 * MiB + 1 * MiB;
constexpr size_t WS_KMLA = WS_QMLA + 52 * MiB;
constexpr size_t WS_VMLA = WS_KMLA + 52 * MiB;
constexpr size_t WS_W2 = WS_VMLA + 36 * MiB;
constexpr size_t W2_SHIFT = WS_W2 - WS_W;
constexpr size_t WS_PART = WS_W2 + 204 * MiB;
constexpr size_t WS_END = WS_PART + 32 * MiB;
static_assert(W_END <= WS_H, "weights overlap h");
static_assert(WS_END <= 1200ull * MiB, "workspace too large");

constexpr int CW_TMO = 0, CW_BAR = 4096, CW_FILL = 8192;

constexpr int RING_BYTES = 131072, LDSCTL_OFF = 143360, MISC_OFF = LDSCTL_OFF + 320, LDS_BYTES = 147456;
constexpr int NWAVES = 8;

#define LDS_WAIT() asm volatile("s_waitcnt lgkmcnt(0)" ::: "memory")
#define VM_WAIT() asm volatile("s_waitcnt vmcnt(0)" ::: "memory")
__device__ __forceinline__ unsigned f2bf(float f) { unsigned u = __builtin_bit_cast(unsigned, f); return (u + 0x7fffu + ((u >> 16) & 1u)) >> 16; }
__device__ __forceinline__ unsigned pk2(float lo, float hi) { return f2bf(lo) | (f2bf(hi) << 16); }
__device__ __forceinline__ unsigned cvt_pk_bf16(float lo, float hi) { unsigned r; asm volatile("v_cvt_pk_bf16_f32 %0, %1, %2" : "=v"(r) : "v"(lo), "v"(hi)); return r; }
__device__ __forceinline__ float bf2f(unsigned short b) { return __builtin_bit_cast(float, (unsigned)b << 16); }
__device__ __forceinline__ float bflo(unsigned w) { return __builtin_bit_cast(float, w << 16); }
__device__ __forceinline__ float bfhi(unsigned w) { return __builtin_bit_cast(float, w & 0xffff0000u); }
__device__ __forceinline__ float shflx(float v, int o, int lane) { return __builtin_bit_cast(float, __builtin_amdgcn_ds_bpermute((lane ^ o) << 2, __builtin_bit_cast(int, v))); }
__device__ __forceinline__ float wave_sum(float v, int lane) {
#pragma unroll
    for (int o = 1; o < 64; o <<= 1) v += shflx(v, o, lane);
    return v;
}
__device__ __forceinline__ float silu_f(float x) { return x * __builtin_amdgcn_rcpf(1.0f + __builtin_amdgcn_exp2f(-x * LOG2E)); }
__device__ __forceinline__ float sigmoid_f(float x) { return __builtin_amdgcn_rcpf(1.0f + __builtin_amdgcn_exp2f(-x * LOG2E)); }

namespace pg8 {
constexpr int BM = 256, BK = 64, HALF = 128, HTB = HALF * BK * 2, STAGE_BYTES = 8 * HTB, NXCD = 8, WGM = 4;
__host__ __device__ __forceinline__ int lds_byte(int r, int c) { const int st = (r >> 4) * 2 + (c >> 5), rr = r & 15, cc = c & 31, ob = rr * 64 + cc * 2; return st * 1024 + (ob ^ (((ob >> 9) & 1) << 5)); }
__host__ __device__ __forceinline__ void stage_rc(int b, int& R, int& C) { const int st = b / 1024, sb = b % 1024, swz = sb ^ (((sb >> 9) & 1) << 5); R = (st >> 1) * 16 + swz / 64; C = (st & 1) * 32 + (swz % 64) / 2; }
__host__ __device__ __forceinline__ int perm32(int rho) { const int n = rho >> 4, i = rho & 15; return 8 * (i >> 2) + 4 * n + (i & 3); }

struct Unit { int pm, pn, z, k0, nt; };
struct Gemm { const bf16_t* A; const bf16_t* Bt; int lda, ldb, K; size_t zA, zB; };

struct StaticOrder {
    int nM, nN, nwg, G, c, ntk;
    __device__ void init(int nM_, int nN_, int G_, int c_, int K_) { nM = nM_; nN = nN_; nwg = nM * nN; G = G_; c = c_; ntk = K_ / BK; }
    __device__ bool tile(int i, Unit& u) const {
        const long L = (long)i * G + c; if (L >= nwg) return false;
        int wgid = (int)L; { const int q = nwg / NXCD, r = nwg % NXCD, xcd = wgid % NXCD, off = wgid / NXCD; wgid = (xcd < r ? xcd * (q + 1) : r * (q + 1) + (xcd - r) * q) + off; }
        const int nig = WGM * nN, gid = wgid / nig, fm = gid * WGM, gsz = (nM - fm) < WGM ? (nM - fm) : WGM;
        u.pm = fm + ((wgid % nig) % gsz); u.pn = (wgid % nig) / gsz; u.z = 0; u.k0 = 0; u.nt = ntk; return true;
    }
    __device__ bool next(int i, Unit& u) const { return tile(i, u); }
};
#ifndef CTX_FIRST
#define CTX_FIRST 1
#endif
struct SplitOrder : StaticOrder {
    int ks;
    __device__ bool next(int i, Unit& u) const {
        if (CTX_FIRST && ks > 0 && nwg % G == 0 && 4 * nN * ks <= G) {
            const int per = nN * ks, rounds = nwg / G;
            if (c < 4 * per) {
                if (i > 0) return i - 1 < rounds ? tile(i - 1, u) : false;
                const int j = c, r = j % per, kz = r % ks, nts = ntk / ks;
                Unit t; t.pm = 64 + j / per; t.pn = r / ks; t.z = kz; t.nt = nts; t.k0 = kz * nts * BK; u = t; return true;
            }
            return i < rounds ? tile(i, u) : false;
        }
        const long L = (long)i * G + c;
        if (L < nwg) return tile(i, u);
        const int j = (int)(L - nwg); const int per = nN * (ks > 0 ? ks : 1), r = j % per, kz = r % (ks > 0 ? ks : 1), nts = ntk / (ks > 0 ? ks : 1);
        Unit t; t.pm = 64 + j / per; t.pn = r / (ks > 0 ? ks : 1); t.z = kz; t.nt = nts; t.k0 = kz * nts * BK; u = t;
        return ks > 0 && j < 4 * per;
    }
};
struct WinOrder : StaticOrder {
    bool trim;
    __device__ bool next(int i, Unit& u) const {
        if (!trim) return tile(i, u);
        const long L = (long)i * G + c;
        if (L < nwg) return tile(i, u);
        const int j = (int)(L - nwg); const int t = j % 6;
        Unit w; w.pm = 64 + j / 6; w.pn = t < 4 ? 12 + t : 16 + t; w.z = 0; w.k0 = 0; w.nt = ntk; u = w; return j < 24;
    }
};
struct MergeOrder : StaticOrder {
    __device__ bool next(int i, Unit& u) const { if (!tile(i / 3, u)) return false; u.z = i % 3; return true; }
};

template <class Epi, class Sched, bool ALIGN_EPI>
__device__ __forceinline__ void gemm_phase(LAS unsigned char* lds, const Gemm g, const Sched& S, const Epi& E) {
    int tid = threadIdx.x; asm volatile("" : "+v"(tid));
    const int wid = __builtin_amdgcn_readfirstlane(tid >> 6), lane = tid & 63, wr = wid >> 2, wc = wid & 3, fr = lane & 15, fq = lane >> 4;
    unsigned voffA[2], voffB[2];
#pragma unroll
    for (int i = 0; i < 2; ++i) { int R, C; stage_rc(tid * 16 + i * 8192, R, C); const int Rb = Epi::PERM ? ((R & ~31) + perm32(R & 31)) : R;
        voffA[i] = (unsigned)(R * g.lda + C) * 2u; voffB[i] = (unsigned)(Rb * g.ldb + C) * 2u; }
    const size_t kstep = (size_t)(BK * 2);
    const size_t hstepA = (size_t)HALF * g.lda * 2, hstepB = (size_t)HALF * g.ldb * 2;
    const size_t tstepA = 2 * hstepA, tstepB = 2 * hstepB;
    const unsigned ldsw = (unsigned)wid * 1024u;
    const int aoff = lds_byte(wr * 64 + fr, fq * 8), boff = lds_byte(wc * 32 + fr, fq * 8);
#define PG8_UA(u) ((const char*)g.A + (size_t)(u).pm * tstepA + (size_t)(u).z * g.zA + (size_t)(u).k0 * 2)
#define PG8_UB(u) ((const char*)g.Bt + (size_t)(u).pn * tstepB + (size_t)(u).z * g.zB + (size_t)(u).k0 * 2)
#define PG8_SA(b, h) (((b) * 2 + (h)) * HTB)
#define PG8_SB(b, h) ((4 + (b) * 2 + (h)) * HTB)
#define PG8_STAGE(bufoff, gbase, voff) do { _Pragma("unroll") for (int _i = 0; _i < 2; ++_i) \
        __builtin_amdgcn_global_load_lds((const unsigned*)((const char*)(gbase) + (voff)[_i]), (LAS unsigned*)(lds + (bufoff) + ldsw + _i * 8192), 16, 0, 0); } while (0)
#define PG8_LDA(dst, b, h) do { _Pragma("unroll") for (int m = 0; m < 4; ++m) _Pragma("unroll") for (int k = 0; k < 2; ++k) dst[m][k] = *(const LAS bf16x8*)(lds + PG8_SA(b, h) + aoff + m * 2048 + k * 1024); } while (0)
#define PG8_LDB(dst, b, h) do { _Pragma("unroll") for (int n = 0; n < 2; ++n) _Pragma("unroll") for (int k = 0; k < 2; ++k) dst[n][k] = *(const LAS bf16x8*)(lds + PG8_SB(b, h) + boff + n * 2048 + k * 1024); } while (0)
#define PG8_MMA(ai, bj, At, Bt) do { __builtin_amdgcn_s_setprio(1); _Pragma("unroll") for (int m = 0; m < 4; ++m) _Pragma("unroll") for (int n = 0; n < 2; ++n) _Pragma("unroll") for (int k = 0; k < 2; ++k) \
        acc[ai][bj][m][n] = __builtin_amdgcn_mfma_f32_16x16x32_bf16(Bt[n][k], At[m][k], acc[ai][bj][m][n], 0, 0, 0); __builtin_amdgcn_s_setprio(0); } while (0)
#define PG8_WAIT_V(n) asm volatile("s_waitcnt vmcnt(" #n ")" ::: "memory")
#define PG8_WAIT_L(n) asm volatile("s_waitcnt lgkmcnt(" #n ")" ::: "memory")
#define PG8_BAR __builtin_amdgcn_s_barrier()
#define PG8_SCHED __builtin_amdgcn_sched_barrier(0)
    Unit cur, nxt; int ui = 0;
    if (!S.next(0, cur)) return;
    f32x4 acc[2][2][4][2];
#pragma unroll
    for (int a = 0; a < 2; ++a)
#pragma unroll
        for (int b = 0; b < 2; ++b)
#pragma unroll
            for (int m = 0; m < 4; ++m)
#pragma unroll
                for (int n = 0; n < 2; ++n) acc[a][b][m][n] = (f32x4){0.f, 0.f, 0.f, 0.f};
    bf16x8 At[4][2], B0[2][2], B1[2][2];
    const char* cA = PG8_UA(cur); const char* cB = PG8_UB(cur);
    PG8_STAGE(PG8_SB(0, 0), cB, voffB); PG8_STAGE(PG8_SB(0, 1), cB + hstepB, voffB); PG8_STAGE(PG8_SA(0, 0), cA, voffA); PG8_STAGE(PG8_SA(0, 1), cA + hstepA, voffA);
    if (wr == 1) PG8_BAR;
    PG8_WAIT_V(2); PG8_BAR;
    PG8_STAGE(PG8_SB(1, 0), cB + kstep, voffB); PG8_STAGE(PG8_SA(1, 0), cA + kstep, voffA); PG8_STAGE(PG8_SB(1, 1), cB + hstepB + kstep, voffB);
    PG8_WAIT_V(6); PG8_BAR;
    for (;;) {
        const bool has_next = S.next(ui + 1, nxt);
        const char* nA = has_next ? PG8_UA(nxt) : cA; const char* nB = has_next ? PG8_UB(nxt) : cB;
        int nt = __builtin_amdgcn_readfirstlane(cur.nt); asm volatile("" : "+s"(nt));
#pragma nounroll
        for (int t = 0; t < nt; t += 2) {
            const bool last = (t == nt - 2);
            const char* a1 = cA + (size_t)(t + 1) * kstep;
            const char* a2 = last ? nA : cA + (size_t)(t + 2) * kstep; const char* b2 = last ? nB : cB + (size_t)(t + 2) * kstep;
            const char* a3 = a2 + kstep; const char* b3 = b2 + kstep;
            PG8_LDB(B0, 0, 0); PG8_LDB(B1, 0, 1); PG8_SCHED; PG8_LDA(At, 0, 0); PG8_STAGE(PG8_SA(1, 1), a1 + hstepA, voffA);
            PG8_WAIT_V(8); PG8_WAIT_L(0); PG8_BAR; PG8_MMA(0, 0, At, B0); PG8_MMA(0, 1, At, B1); PG8_BAR; PG8_SCHED;
            PG8_LDA(At, 0, 1); PG8_STAGE(PG8_SB(0, 0), b2, voffB); PG8_STAGE(PG8_SB(0, 1), b2 + hstepB, voffB); PG8_STAGE(PG8_SA(0, 0), a2, voffA);
            PG8_WAIT_V(8); PG8_WAIT_L(0); PG8_BAR; PG8_MMA(1, 0, At, B0); PG8_MMA(1, 1, At, B1); PG8_BAR; PG8_SCHED;
            PG8_LDB(B0, 1, 0); PG8_LDB(B1, 1, 1); PG8_SCHED; PG8_LDA(At, 1, 0); PG8_STAGE(PG8_SA(0, 1), a2 + hstepA, voffA);
            PG8_WAIT_V(8); PG8_WAIT_L(0); PG8_BAR; PG8_MMA(0, 0, At, B0); PG8_MMA(0, 1, At, B1); PG8_BAR; PG8_SCHED;
            PG8_LDA(At, 1, 1); PG8_STAGE(PG8_SB(1, 0), b3, voffB); PG8_STAGE(PG8_SB(1, 1), b3 + hstepB, voffB); PG8_STAGE(PG8_SA(1, 0), a3, voffA);
            PG8_WAIT_V(8); PG8_WAIT_L(0); PG8_BAR; PG8_MMA(1, 0, At, B0); PG8_MMA(1, 1, At, B1); PG8_BAR; PG8_SCHED;
        }
        if constexpr (ALIGN_EPI) { if (wr == 0) PG8_BAR; }
        { int fr_ = fr, fq_ = fq; asm volatile("" : "+v"(fr_), "+v"(fq_));
          E(acc, cur, wr, wc, fr_, fq_); }
        if (!has_next) break;
        if (!(Epi::KEEP && cur.z < 2)) {
#pragma unroll
        for (int a = 0; a < 2; ++a)
#pragma unroll
            for (int b = 0; b < 2; ++b)
#pragma unroll
                for (int m = 0; m < 4; ++m)
#pragma unroll
                    for (int n = 0; n < 2; ++n) acc[a][b][m][n] = (f32x4){0.f, 0.f, 0.f, 0.f};
        }
        cur = nxt; cA = nA; cB = nB; ++ui;
        if constexpr (ALIGN_EPI) { if (wr == 1) PG8_BAR; }
    }
    PG8_WAIT_V(0);
    if constexpr (!ALIGN_EPI) { if (wr == 0) PG8_BAR; }
    PG8_BAR;
#undef PG8_UA
#undef PG8_UB
#undef PG8_SA
#undef PG8_SB
#undef PG8_STAGE
#undef PG8_LDA
#undef PG8_LDB
#undef PG8_MMA
#undef PG8_WAIT_V
#undef PG8_WAIT_L
#undef PG8_BAR
#undef PG8_SCHED
}

typedef f32x4 (&AccRef)[2][2][4][2];

__device__ __forceinline__ void store8(bf16_t* p, f32x4 v0, f32x4 v1) {
    u32x4 w; w.x = cvt_pk_bf16(v0[0], v0[1]); w.y = cvt_pk_bf16(v0[2], v0[3]); w.z = cvt_pk_bf16(v1[0], v1[1]); w.w = cvt_pk_bf16(v1[2], v1[3]);
    *(u32x4*)p = w;
}
__device__ __forceinline__ void store4(bf16_t* p, f32x4 v) { u32x2 w; w.x = cvt_pk_bf16(v[0], v[1]); w.y = cvt_pk_bf16(v[2], v[3]); *(u32x2*)p = w; }

struct EpiSwiGLU {
    static constexpr bool PERM = true, KEEP = false;
    bf16_t* O;
    __device__ __forceinline__ void operator()(AccRef acc, const Unit& u, int wr, int wc, int fr, int fq) const {
        const int row0 = u.pm * BM + wr * 64 + fr, col0 = u.pn * 128 + wc * 32 + 8 * fq;
#pragma unroll
        for (int ai = 0; ai < 2; ++ai)
#pragma unroll
            for (int m = 0; m < 4; ++m) {
                f32x4 h0, h1;
#pragma unroll
                for (int e = 0; e < 4; ++e) { h0[e] = silu_f(acc[ai][0][m][0][e]) * acc[ai][1][m][0][e]; h1[e] = silu_f(acc[ai][0][m][1][e]) * acc[ai][1][m][1][e]; }
                store8(O + (size_t)(row0 + ai * HALF + m * 16) * FF + col0, h0, h1);
            }
    }
};

struct EpiResid {
    static constexpr bool PERM = false, KEEP = false;
    const float* base_lat; const float* base_ctx; float* out; const float* modl; int midx; float coef;
    float* part;
    __device__ __forceinline__ void operator()(AccRef acc, const Unit& u, int wr, int wc, int fr, int fq) const {
        const bool split = part != nullptr && u.pm >= 64;
        const int mrow = u.pm < 64 ? (u.pm >> 4) : 4;
        const float* mp = modl + (size_t)mrow * MODW + midx * DM;
        const unsigned long long slab = (unsigned long long)part + ((size_t)u.z * TC + (size_t)(u.pm - 64) * BM) * DM * 4;
        const unsigned long long ba = split ? slab : (unsigned long long)base_lat + (size_t)u.pm * BM * DM * 4;
        const unsigned long long oa = split ? slab : (unsigned long long)out + (size_t)u.pm * BM * DM * 4;
        const float* bp = (const float*)(const GAS float*)ba; float* op = (float*)(GAS float*)oa;
        const int odd = fr & 1;
        const int colo = u.pn * BM + wc * 32 + 4 * fq;
        const int col0 = colo + 16 * odd;
        f32x4 gv[2][2];
#pragma unroll
        for (int bj = 0; bj < 2; ++bj)
#pragma unroll
            for (int n = 0; n < 2; ++n) { gv[bj][n] = *(const f32x4*)(mp + colo + bj * HALF + n * 16) * coef; if (split) gv[bj][n] = (f32x4){1.f, 1.f, 1.f, 1.f}; }
#pragma unroll
        for (int ai = 0; ai < 2; ++ai) {
            f32x4 b[4][2][2];
#pragma unroll
            for (int m = 0; m < 4; ++m) { const size_t off = (size_t)(ai * HALF + wr * 64 + m * 16 + (fr & ~1)) * DM + col0;
#pragma unroll
                for (int bj = 0; bj < 2; ++bj)
#pragma unroll
                    for (int pr = 0; pr < 2; ++pr) { b[m][bj][pr] = (f32x4){0.f, 0.f, 0.f, 0.f}; if (!split) b[m][bj][pr] = *(const f32x4*)(bp + off + (size_t)pr * DM + bj * HALF); } }
            asm volatile("" ::: "memory");
#pragma unroll
            for (int m = 0; m < 4; ++m) { const size_t off = (size_t)(ai * HALF + wr * 64 + m * 16 + (fr & ~1)) * DM + col0;
#pragma unroll
                for (int bj = 0; bj < 2; ++bj) {
                    const f32x4 a0 = gv[bj][0] * acc[ai][bj][m][0], a1 = gv[bj][1] * acc[ai][bj][m][1];
                    f32x4 t;
#pragma unroll
                    for (int e = 0; e < 4; ++e) { const float sv = odd ? a0[e] : a1[e];
                        t[e] = __builtin_bit_cast(float, __builtin_amdgcn_mov_dpp(__builtin_bit_cast(int, sv), 0xB1, 0xF, 0xF, true)); }
                    f32x4 p0, p1;
#pragma unroll
                    for (int e = 0; e < 4; ++e) { p0[e] = odd ? t[e] : a0[e]; p1[e] = odd ? a1[e] : t[e]; }
                    *(f32x4*)(op + off + bj * HALF) = b[m][bj][0] + p0;
                    *(f32x4*)(op + off + (size_t)DM + bj * HALF) = b[m][bj][1] + p1; } }
            asm volatile("" ::: "memory");
        }
    }
};

struct EpiWin {
    static constexpr bool PERM = true, KEEP = false;
    bf16_t *pconv, *pmla, *pgqa, *pgate; float* ssq; const float* cos64; const float* sin64;
    __device__ __forceinline__ void plain(AccRef acc, bf16_t* O, int ldc, int colt, const Unit& u, int wr, int wc, int fr, int fq) const {
        const int row0 = u.pm * BM + wr * 64 + fr, col0 = colt + wc * 32 + 8 * fq;
#pragma unroll
        for (int ai = 0; ai < 2; ++ai)
#pragma unroll
            for (int m = 0; m < 4; ++m) { bf16_t* rowp = O + (size_t)(row0 + ai * HALF + m * 16) * ldc + col0;
#pragma unroll
                for (int bj = 0; bj < 2; ++bj) store8(rowp + bj * HALF, acc[ai][bj][m][0], acc[ai][bj][m][1]); }
    }
    __device__ __forceinline__ void operator()(AccRef acc, const Unit& u, int wr, int wc, int fr, int fq) const {
        const int pn = u.pn;
        if (pn < 12) { plain(acc, pconv, 3072, pn * 256, u, wr, wc, fr, fq); }
        else if (pn < 16) {
            plain(acc, pmla, 1024, (pn - 12) * 256, u, wr, wc, fr, fq);
            if (pn < 15) {
#pragma unroll
                for (int ai = 0; ai < 2; ++ai)
#pragma unroll
                    for (int m = 0; m < 4; ++m) { float s = 0.f;
#pragma unroll
                        for (int bj = 0; bj < 2; ++bj)
#pragma unroll
                            for (int n = 0; n < 2; ++n) { const f32x4 x = acc[ai][bj][m][n]; s += (x[0] * x[0] + x[1] * x[1]) + (x[2] * x[2] + x[3] * x[3]); }
                        s += shflx(s, 16, fr + 16 * fq); s += shflx(s, 32, fr + 16 * fq);
                        if (fq == 0) ssq[(size_t)(u.pm * BM + ai * HALF + wr * 64 + m * 16 + fr) * 16 + (pn - 12) * 4 + wc] = s; }
            }
        }
        else if (pn < 21) {
            const bool lat = u.pm < 64; const bool rowtype = wc < 2;
            const int i0 = 16 * (wc & 1) + 4 * fq, d1base = rowtype ? (16 * wc + 4 * fq) : (16 * wc + 4 * fq + 32);
            const int rpos = (4 * u.pm + 2 * 0 + wr) & 63;
            f32x4 csv[2][4], snv[2][4];
#pragma unroll
            for (int ai = 0; ai < 2; ++ai)
#pragma unroll
                for (int m = 0; m < 4; ++m) { const int pos = rowtype ? ((rpos + 2 * ai) & 63) : (16 * m + fr); csv[ai][m] = *(const f32x4*)(cos64 + pos * 32 + i0); snv[ai][m] = *(const f32x4*)(sin64 + pos * 32 + i0); }
            asm volatile("" ::: "memory");
#pragma unroll
            for (int ai = 0; ai < 2; ++ai)
#pragma unroll
                for (int m = 0; m < 4; ++m) {
                    f32x4 cs = csv[ai][m], sn = snv[ai][m];
                    if (!lat) { cs = (f32x4){1.f, 1.f, 1.f, 1.f}; sn = (f32x4){0.f, 0.f, 0.f, 0.f}; }
                    bf16_t* rowp = pgqa + (size_t)(u.pm * BM + ai * HALF + wr * 64 + m * 16 + fr) * 1536 + (2 * (pn - 16)) * 128 + d1base;
#pragma unroll
                    for (int bj = 0; bj < 2; ++bj) { const f32x4 x1 = acc[ai][bj][m][0], x2 = acc[ai][bj][m][1];
                        store4(rowp + bj * 128, x1 * cs - x2 * sn); store4(rowp + bj * 128 + 32, x1 * sn + x2 * cs); }
                }
        }
        else if (pn == 21) { plain(acc, pgqa, 1536, 1280, u, wr, wc, fr, fq); }
        else {
            const int row0 = u.pm * BM + wr * 64 + fr, col0 = (pn - 22) * 256 + wc * 32 + 8 * fq;
#pragma unroll
            for (int ai = 0; ai < 2; ++ai)
#pragma unroll
                for (int m = 0; m < 4; ++m) { bf16_t* rowp = pgate + (size_t)(row0 + ai * HALF + m * 16) * 6144 + col0;
#pragma unroll
                    for (int bj = 0; bj < 2; ++bj) { f32x4 a, b;
#pragma unroll
                        for (int e = 0; e < 4; ++e) { a[e] = sigmoid_f(acc[ai][bj][m][0][e]); b[e] = sigmoid_f(acc[ai][bj][m][1][e]); }
                        store8(rowp + bj * HALF, a, b); } }
        }
    }
};

struct EpiMlaQ {
    static constexpr bool PERM = true, KEEP = false;
    bf16_t* Q; const float* ssq; const float* cos32; const float* sin32;
    __device__ __forceinline__ void operator()(AccRef acc, const Unit& u, int wr, int wc, int fr, int fq) const {
        const int pn = u.pn; const bool lat = u.pm < 64;
        const int rpos = (4 * u.pm + wr) & 63;
        float rq[2][4]; f32x4 sq0[2][4], sq1[2][4];
#pragma unroll
        for (int ai = 0; ai < 2; ++ai)
#pragma unroll
            for (int m = 0; m < 4; ++m) { const int row = u.pm * BM + ai * HALF + wr * 64 + m * 16 + fr; sq0[ai][m] = *(const f32x4*)(ssq + (size_t)row * 16); sq1[ai][m] = *(const f32x4*)(ssq + (size_t)row * 16 + 4); }
        asm volatile("" ::: "memory");
#pragma unroll
        for (int ai = 0; ai < 2; ++ai)
#pragma unroll
            for (int m = 0; m < 4; ++m) { const f32x4 s0 = sq0[ai][m], s1 = sq1[ai][m];
                rq[ai][m] = __builtin_amdgcn_rsqf(((s0[0] + s0[1]) + (s0[2] + s0[3]) + (s1[0] + s1[1]) + (s1[2] + s1[3])) * (1.0f / 512.0f) + EPS); }
        if (pn < 4) {
#pragma unroll
            for (int ai = 0; ai < 2; ++ai)
#pragma unroll
                for (int m = 0; m < 4; ++m) { const int row = u.pm * BM + ai * HALF + wr * 64 + m * 16 + fr;
#pragma unroll
                    for (int bj = 0; bj < 2; ++bj) store8(Q + (size_t)row * 1536 + (2 * pn + bj) * 192 + wc * 32 + 8 * fq, acc[ai][bj][m][0] * rq[ai][m], acc[ai][bj][m][1] * rq[ai][m]); }
        } else {
            const bool rowtype = (wc & 1) == 0; const int d1base = rowtype ? 4 * fq : 32 + 4 * fq;
#pragma unroll
            for (int ai = 0; ai < 2; ++ai) {
                f32x4 cs[4], sn[4];
#pragma unroll
                for (int m = 0; m < 4; ++m) { cs[m] = (f32x4){1.f, 1.f, 1.f, 1.f}; sn[m] = (f32x4){0.f, 0.f, 0.f, 0.f};
                    if (lat) { const int pos = rowtype ? ((rpos + 2 * ai) & 63) : (16 * m + fr); cs[m] = *(const f32x4*)(cos32 + pos * 16 + 4 * fq); sn[m] = *(const f32x4*)(sin32 + pos * 16 + 4 * fq); } }
#pragma unroll
                for (int m = 0; m < 4; ++m) { const int row = u.pm * BM + ai * HALF + wr * 64 + m * 16 + fr;
#pragma unroll
                    for (int bj = 0; bj < 2; ++bj) { const int head = 2 * (2 * (pn - 4) + bj) + (wc >> 1);
                        const f32x4 x1 = acc[ai][bj][m][0] * rq[ai][m], x2 = acc[ai][bj][m][1] * rq[ai][m];
                        bf16_t* p = Q + (size_t)row * 1536 + head * 192 + 128 + d1base;
                        store4(p, x1 * cs[m] - x2 * sn[m]); store4(p + 16, x1 * sn[m] + x2 * cs[m]); } }
            }
        }
    }
};
struct EpiMlaKV {
    static constexpr bool PERM = true, KEEP = false;
    bf16_t* KM; bf16_t* VM; const float* ssq;
    __device__ __forceinline__ void operator()(AccRef acc, const Unit& u, int wr, int wc, int fr, int fq) const {
        const int h = u.pn;
        float rk[2][4]; f32x4 sk[2][4];
#pragma unroll
        for (int ai = 0; ai < 2; ++ai)
#pragma unroll
            for (int m = 0; m < 4; ++m) { const int row = u.pm * BM + ai * HALF + wr * 64 + m * 16 + fr; sk[ai][m] = *(const f32x4*)(ssq + (size_t)row * 16 + 8); }
        asm volatile("" ::: "memory");
#pragma unroll
        for (int ai = 0; ai < 2; ++ai)
#pragma unroll
            for (int m = 0; m < 4; ++m) rk[ai][m] = __builtin_amdgcn_rsqf(((sk[ai][m][0] + sk[ai][m][1]) + (sk[ai][m][2] + sk[ai][m][3])) * (1.0f / 256.0f) + EPS);
#pragma unroll
        for (int ai = 0; ai < 2; ++ai)
#pragma unroll
            for (int m = 0; m < 4; ++m) { const int row = u.pm * BM + ai * HALF + wr * 64 + m * 16 + fr;
                store8(KM + (size_t)row * 1536 + h * 192 + wc * 32 + 8 * fq, acc[ai][0][m][0] * rk[ai][m], acc[ai][0][m][1] * rk[ai][m]);
                store8(VM + (size_t)row * 1024 + h * 128 + wc * 32 + 8 * fq, acc[ai][1][m][0] * rk[ai][m], acc[ai][1][m][1] * rk[ai][m]); }
    }
};
struct EpiMerge {
    static constexpr bool PERM = true, KEEP = true;
    const bf16_t* gate; bf16_t* O;
    __device__ __forceinline__ static f32x4 gclamp(unsigned lo, unsigned hi) { f32x4 g = (f32x4){bflo(lo), bfhi(lo), bflo(hi), bfhi(hi)};
#pragma unroll
        for (int e = 0; e < 4; ++e) g[e] = fmaxf(g[e], 1e-4f);
        return g; }
    __device__ __forceinline__ void operator()(AccRef acc, const Unit& u, int wr, int wc, int fr, int fq) const {
        const int col0 = u.pn * BM + wc * 32 + 8 * fq;
#pragma unroll
        for (int ai = 0; ai < 2; ++ai)
#pragma unroll
            for (int mh = 0; mh < 2; ++mh) {
                u32x4 ga[2][2], gb[2][2];
#pragma unroll
                for (int mm = 0; mm < 2; ++mm) { const int m = mh * 2 + mm; const size_t row = (size_t)(u.pm * BM + ai * HALF + wr * 64 + m * 16 + fr);
#pragma unroll
                    for (int bj = 0; bj < 2; ++bj) { const bf16_t* gp = gate + row * 6144 + u.z * 2048 + col0 + bj * HALF; ga[mm][bj] = *(const u32x4*)gp;
                        gb[mm][bj] = *(const u32x4*)(gp + (u.z < 2 ? 2048 : 0)); } }
                asm volatile("" ::: "memory");
#pragma unroll
                for (int mm = 0; mm < 2; ++mm) { const int m = mh * 2 + mm; const size_t row = (size_t)(u.pm * BM + ai * HALF + wr * 64 + m * 16 + fr);
#pragma unroll
                    for (int bj = 0; bj < 2; ++bj) {
                        const f32x4 a0 = gclamp(ga[mm][bj].x, ga[mm][bj].y), a1 = gclamp(ga[mm][bj].z, ga[mm][bj].w);
                        if (u.z < 2) {
                            const f32x4 b0 = gclamp(gb[mm][bj].x, gb[mm][bj].y), b1 = gclamp(gb[mm][bj].z, gb[mm][bj].w);
#pragma unroll
                            for (int e = 0; e < 4; ++e) { acc[ai][bj][m][0][e] *= a0[e] * __builtin_amdgcn_rcpf(b0[e]); acc[ai][bj][m][1][e] *= a1[e] * __builtin_amdgcn_rcpf(b1[e]); }
                        } else store8(O + row * DM + col0 + bj * HALF, acc[ai][bj][m][0] * a0, acc[ai][bj][m][1] * a1);
                    } }
                asm volatile("" ::: "memory");
            }
    }
};
}

namespace att {
constexpr int NW = 8, QBLK = 32, KVBLK = 64;
constexpr int SHM_V = KVBLK * 128 * 2;
#define SBAR() __builtin_amdgcn_sched_barrier(0)
__device__ __forceinline__ int crow(int r, int hi) { return (r & 3) + 8 * (r >> 2) + 4 * hi; }
__device__ __forceinline__ bf16x8 ld8(const bf16_t* p) { return *reinterpret_cast<const bf16x8*>(p); }

template <int DQK> struct SM {
    static constexpr float SCALE = DQK == 192 ? 0.07216878364870322f : 0.08838834764831845f;
    static constexpr float C = SCALE * LOG2E;
    static constexpr float THRS = 8.f / SCALE;
    __device__ static __forceinline__ void partialSM(f32x16& p0, f32x16& p1, float& m_reg, float& mn, float& alpha) {
        float pmax = p0[0];
#pragma unroll
        for (int r = 1; r < 16; ++r) pmax = fmaxf(pmax, p0[r]);
#pragma unroll
        for (int r = 0; r < 16; ++r) pmax = fmaxf(pmax, p1[r]);
        { auto rr = __builtin_amdgcn_permlane32_swap(__float_as_uint(pmax), __float_as_uint(pmax), false, false);
          pmax = fmaxf(__uint_as_float(rr[0]), __uint_as_float(rr[1])); }
        if (__builtin_expect(__all(pmax - m_reg <= THRS), 1)) { mn = m_reg; alpha = 1.f; }
        else { mn = fmaxf(m_reg, pmax); alpha = __builtin_amdgcn_exp2f((m_reg - mn) * C); m_reg = mn; }
        const float mnC = -mn * C;
#pragma unroll
        for (int r = 0; r < 16; ++r) p0[r] = fmaf(p0[r], C, mnC);
#pragma unroll
        for (int r = 0; r < 16; ++r) p1[r] = fmaf(p1[r], C, mnC);
#pragma unroll
        for (int r = 0; r < 16; ++r) p0[r] = __builtin_amdgcn_exp2f(p0[r]);
    }
};
__device__ __forceinline__ void finishSM(f32x16& p0, f32x16& p1, float alpha, float& l_reg, bf16x8& pa0, bf16x8& pa1, bf16x8& pa2, bf16x8& pa3) {
#pragma unroll
    for (int r = 0; r < 16; ++r) p1[r] = __builtin_amdgcn_exp2f(p1[r]);
    float ps = 0;
#pragma unroll
    for (int r = 0; r < 16; ++r) ps += p0[r];
#pragma unroll
    for (int r = 0; r < 16; ++r) ps += p1[r];
    { auto rr = __builtin_amdgcn_permlane32_swap(__float_as_uint(ps), __float_as_uint(ps), false, false);
      ps = __uint_as_float(rr[0]) + __uint_as_float(rr[1]); }
    l_reg = l_reg * alpha + ps;
#define PK4(P, BASE, OUT) do { unsigned a0 = cvt_pk_bf16(P[BASE + 0], P[BASE + 1]), a1 = cvt_pk_bf16(P[BASE + 2], P[BASE + 3]);   \
    unsigned b0 = cvt_pk_bf16(P[BASE + 4], P[BASE + 5]), b1 = cvt_pk_bf16(P[BASE + 6], P[BASE + 7]);                              \
    auto r0 = __builtin_amdgcn_permlane32_swap(a0, b0, false, false); auto r1 = __builtin_amdgcn_permlane32_swap(a1, b1, false, false); \
    u32x4 w = {r0[0], r1[0], r0[1], r1[1]}; OUT = *reinterpret_cast<bf16x8*>(&w); } while (0)
    PK4(p0, 0, pa0); PK4(p0, 8, pa1); PK4(p1, 0, pa2); PK4(p1, 8, pa3);
#undef PK4
}
template <int DQK, int NREG> __device__ __forceinline__ void qkt(f32x16& p0, f32x16& p1, const char* Ks, const bf16x8* qr, const char* qst, int r32, int hi) {
    constexpr int RS = DQK * 2;
    p0 = f32x16{}; p1 = f32x16{};
#pragma unroll
    for (int d0 = 0; d0 < DQK / 16; ++d0) { const int cb = (d0 * 16 + hi * 8) * 2;
        const bf16x8 b0 = *reinterpret_cast<const bf16x8*>(Ks + r32 * RS + (cb ^ ((r32 & 7) << 4)));
        const bf16x8 b1 = *reinterpret_cast<const bf16x8*>(Ks + (32 + r32) * RS + (cb ^ ((r32 & 7) << 4)));
        const bf16x8 q = d0 < NREG ? qr[d0 < NREG ? d0 : 0] : *reinterpret_cast<const bf16x8*>(qst + (d0 - NREG) * 1024);
        p0 = __builtin_amdgcn_mfma_f32_32x32x16_bf16(b0, q, p0, 0, 0, 0);
        p1 = __builtin_amdgcn_mfma_f32_32x32x16_bf16(b1, q, p1, 0, 0, 0); }
}
__device__ __forceinline__ int v_st(int k, int c) { const int kk = (k & ~0xC) | ((k & 4) << 1) | ((k & 8) >> 1); return ((kk >> 3) * 4 + (c >> 5)) * 512 + ((kk & 7) * 32 + (c & 31)) * 2; }
__device__ __forceinline__ int v_rd_base(int lane) { return ((lane & 3) << 3) | (((lane >> 2) & 3) << 6) | (((lane >> 4) & 1) << 5) | (((lane >> 5) & 1) << 8); }
constexpr int v_rd_off(int d0, int ks, int half) { return d0 * 512 + ks * 4096 + half * 2048; }
template <int OFF> __device__ __forceinline__ s16x4 tr_read(int vb) {
    s16x4 r; asm volatile("ds_read_b64_tr_b16 %0, %1 offset:%2" : "=&v"(r) : "v"(vb), "i"(OFF) : "memory"); return r;
}
template <int D0> __device__ __forceinline__ void pv_one(f32x16& od, int vb, bf16x8 pa0, bf16x8 pa1, bf16x8 pa2, bf16x8 pa3) {
    const s16x4 l0 = tr_read<v_rd_off(D0, 0, 0)>(vb), h0 = tr_read<v_rd_off(D0, 0, 1)>(vb), l1 = tr_read<v_rd_off(D0, 1, 0)>(vb), h1 = tr_read<v_rd_off(D0, 1, 1)>(vb);
    const s16x4 l2 = tr_read<v_rd_off(D0, 2, 0)>(vb), h2 = tr_read<v_rd_off(D0, 2, 1)>(vb), l3 = tr_read<v_rd_off(D0, 3, 0)>(vb), h3 = tr_read<v_rd_off(D0, 3, 1)>(vb);
    asm volatile("s_waitcnt lgkmcnt(0)" ::: "memory"); SBAR();
#define PK(L, H) (bf16x8){L[0], L[1], L[2], L[3], H[0], H[1], H[2], H[3]}
    od = __builtin_amdgcn_mfma_f32_32x32x16_bf16(pa0, PK(l0, h0), od, 0, 0, 0);
    od = __builtin_amdgcn_mfma_f32_32x32x16_bf16(pa1, PK(l1, h1), od, 0, 0, 0);
    od = __builtin_amdgcn_mfma_f32_32x32x16_bf16(pa2, PK(l2, h2), od, 0, 0, 0);
    od = __builtin_amdgcn_mfma_f32_32x32x16_bf16(pa3, PK(l3, h3), od, 0, 0, 0);
#undef PK
}
__device__ __forceinline__ void pv_d0(f32x16* o, int vb, bf16x8 pa0, bf16x8 pa1, bf16x8 pa2, bf16x8 pa3) {
    pv_one<0>(o[0], vb, pa0, pa1, pa2, pa3); pv_one<1>(o[1], vb, pa0, pa1, pa2, pa3); pv_one<2>(o[2], vb, pa0, pa1, pa2, pa3); pv_one<3>(o[3], vb, pa0, pa1, pa2, pa3);
}

#ifndef ATT_NREGQ
#define ATT_NREGQ 12
#endif
template <int DQK, int LDQ, int LDK, int LDV, int LDO, bool WINDOW, bool SINK>
__device__ __forceinline__ void attn_unit(const bf16_t* __restrict__ Qb, const bf16_t* __restrict__ Kb, const bf16_t* __restrict__ Vb, bf16_t* __restrict__ Ob,
                                          int rowA0, int nA, int rowB0, int NT, int qpos0, int kposB0, float sinkl2, char* lds) {
    constexpr int RS = DQK * 2, SHM_K = KVBLK * DQK * 2, NKC = DQK / 64, ND0 = DQK / 16, NREG = ND0 > 8 ? ATT_NREGQ : ND0, GPR = DQK / 8;
    using S = SM<DQK>;
    int tid = threadIdx.x; asm volatile("" : "+v"(tid));
    const int wid = __builtin_amdgcn_readfirstlane(tid >> 6), lane = tid & 63, r32 = lane & 31, hi = lane >> 5;
    char* V_lds = lds; char* K_lds = lds + 2 * SHM_V;
    float* ws = (float*)(lds + 2 * SHM_V + 3 * SHM_K) + wid * 64; float* li_l = ws; float* al_l = ws + 32;
    float m_reg = -1e30f, l_reg = 0; f32x16 o[4] = {}; bf16x8 qr[NREG];
    const bf16_t* Qw = Qb + (long)(wid * QBLK + r32) * LDQ + hi * 8;
    char* qst = lds + 2 * SHM_V + 3 * SHM_K + NW * 64 * 4 + wid * ((ND0 - NREG) * 1024) + lane * 16;
#pragma unroll
    for (int d0 = 0; d0 < NREG; ++d0) qr[d0] = ld8(Qw + d0 * 16);
#pragma unroll
    for (int d0 = NREG; d0 < ND0; ++d0) *reinterpret_cast<bf16x8*>(qst + (d0 - NREG) * 1024) = ld8(Qw + d0 * 16);
    unsigned voffK[NKC], voffV[2];
#pragma unroll
    for (int i = 0; i < NKC; ++i) { const int G = (i * 8 + wid) * 64 + lane, r = G / GPR, gp = G - r * GPR, g = gp ^ (r & 7); voffK[i] = (unsigned)(r * LDK + g * 8) * 2u; }
#pragma unroll
    for (int i = 0; i < 2; ++i) { const int G = (i * 8 + wid) * 64 + lane, st = G >> 5, kk = (st >> 2) * 8 + ((G >> 2) & 7), c = (st & 3) * 32 + (G & 3) * 8;
        const int k = (kk & ~0xC) | ((kk & 4) << 1) | ((kk & 8) >> 1); voffV[i] = (unsigned)(k * LDV + c) * 2u; }
    const unsigned ldsw = (unsigned)wid * 1024u;
    LAS unsigned char* Kl = (LAS unsigned char*)K_lds; LAS unsigned char* Vl = (LAS unsigned char*)V_lds;
    const int vb0 = (int)(uintptr_t)V_lds + v_rd_base(lane);
#define KROW(t) ((t) < nA ? rowA0 + (t) * KVBLK : rowB0 + ((t) - nA) * KVBLK)
#define KDMA(t, slot) do { const char* kb_ = (const char*)(Kb + (long)KROW(t) * LDK); _Pragma("unroll") for (int i_ = 0; i_ < NKC; ++i_) \
        __builtin_amdgcn_global_load_lds((const unsigned*)(kb_ + voffK[i_]), (LAS unsigned*)(Kl + (slot) * SHM_K + ldsw + i_ * 8192), 16, 0, 0); } while (0)
#define VDMA(t, slot) do { const char* vb_ = (const char*)(Vb + (long)KROW(t) * LDV); _Pragma("unroll") for (int i_ = 0; i_ < 2; ++i_) \
        __builtin_amdgcn_global_load_lds((const unsigned*)(vb_ + voffV[i_]), (LAS unsigned*)(Vl + (slot) * SHM_V + ldsw + i_ * 8192), 16, 0, 0); } while (0)
#define RESC(a) do { if (__any((a) < 1.f)) { if (hi == 0) al_l[r32] = (a); asm volatile("s_waitcnt lgkmcnt(0)" ::: "memory"); \
    _Pragma("unroll") for (int d = 0; d < 4; ++d) _Pragma("unroll") for (int r = 0; r < 16; ++r) o[d][r] *= al_l[crow(r, hi)]; } } while (0)
#define MASK(P0, P1, t) do { if (WINDOW && (t) >= nA) { const int kj0_ = kposB0 + ((t) - nA) * KVBLK - (qpos0 + wid * QBLK + r32); \
    _Pragma("unroll") for (int r = 0; r < 16; ++r) { const int dk_ = kj0_ + crow(r, hi); if (dk_ > 128 || dk_ < -128) P0[r] = -INFINITY; if (dk_ + 32 > 128 || dk_ + 32 < -128) P1[r] = -INFINITY; } } } while (0)
#define LBAR() do { asm volatile("s_waitcnt lgkmcnt(0)" ::: "memory"); __builtin_amdgcn_s_barrier(); asm volatile("" ::: "memory"); } while (0)
#define STEP_END(more) do { if (more) { if (NKC == 3) asm volatile("s_waitcnt vmcnt(3)" ::: "memory"); else asm volatile("s_waitcnt vmcnt(2)" ::: "memory"); } else asm volatile("s_waitcnt vmcnt(0)" ::: "memory"); \
    LBAR(); { const int t_ = kcur; kcur = knext; knext = kfree; kfree = t_; } vsl ^= 1; } while (0)
#define STEP(j, C0, C1, mnC, alC, P0, P1, alP) do { const bool more_ = (j) + 2 < NT; VDMA(j, vsl); if (more_) KDMA((j) + 2, kfree); SBAR(); \
    qkt<DQK, NREG>(C0, C1, K_lds + kcur * SHM_K, qr, qst, r32, hi); MASK(C0, C1, j); \
    finishSM(P0, P1, alP, l_reg, pa0, pa1, pa2, pa3); SBAR(); \
    pv_d0(o, vb0 + (vsl ^ 1) * SHM_V, pa0, pa1, pa2, pa3); S::partialSM(C0, C1, m_reg, mnC, alC); \
    RESC(alC); STEP_END(more_); } while (0)
    f32x16 pA0, pA1, pB0, pB1; float mnA, mnB, alA, alB; bf16x8 pa0, pa1, pa2, pa3;
    int kcur = 0, knext = 1, kfree = 2, vsl = 0;
    KDMA(0, 0); KDMA(1, 1);
    asm volatile("s_waitcnt vmcnt(0)" ::: "memory"); LBAR();
    { const bool more_ = 2 < NT; VDMA(0, vsl); if (more_) KDMA(2, kfree); SBAR();
      qkt<DQK, NREG>(pA0, pA1, K_lds + kcur * SHM_K, qr, qst, r32, hi); MASK(pA0, pA1, 0); S::partialSM(pA0, pA1, m_reg, mnA, alA);
      STEP_END(more_); }
    for (int j = 1; j + 1 < NT; j += 2) {
        STEP(j, pB0, pB1, mnB, alB, pA0, pA1, alA);
        STEP(j + 1, pA0, pA1, mnA, alA, pB0, pB1, alB);
    }
    STEP(NT - 1, pB0, pB1, mnB, alB, pA0, pA1, alA);
    finishSM(pB0, pB1, alB, l_reg, pa0, pa1, pa2, pa3); SBAR();
    pv_d0(o, vb0 + (vsl ^ 1) * SHM_V, pa0, pa1, pa2, pa3);
    if (SINK) l_reg += __builtin_amdgcn_exp2f(sinkl2 - m_reg * S::C);
    if (hi == 0) li_l[r32] = l_reg; asm volatile("s_waitcnt lgkmcnt(0)" ::: "memory");
    float rli[16];
#pragma unroll
    for (int r = 0; r < 16; ++r) rli[r] = __builtin_amdgcn_rcpf(li_l[crow(r, hi)]);
    bf16_t* Ow = Ob + (long)(wid * QBLK) * LDO;
#pragma unroll
    for (int r = 0; r < 16; ++r) { const int orow = crow(r, hi);
#pragma unroll
        for (int d0 = 0; d0 < 4; ++d0) Ow[(long)orow * LDO + d0 * 32 + r32] = (bf16_t)f2bf(o[d0][r] * rli[r]); }
    __syncthreads();
#undef KROW
#undef KDMA
#undef VDMA
#undef RESC
#undef MASK
#undef STEP
#undef STEP_END
#undef LBAR
}
#undef SBAR
}

#define XB_TMO      128
#define XB_XCNT(j)  (256  + 64 * (j))
#define XB_XSUB(j)  (1280 + 64 * (j))
#define XB_XGEN(j)  (2304 + 64 * (j))
#define XB_TOP      3328
#define XB_TOPGEN   3392
#define XCD_BAR_WORDS 3456
#define XB_SPIN_CAP (1u << 18)
__device__ __forceinline__ unsigned xb_ld(unsigned* p)              { return __hip_atomic_load(p, __ATOMIC_RELAXED, __HIP_MEMORY_SCOPE_AGENT); }
__device__ __forceinline__ unsigned xb_add(unsigned* p, unsigned v) { return __hip_atomic_fetch_add(p, v, __ATOMIC_RELAXED, __HIP_MEMORY_SCOPE_AGENT); }
__device__ __forceinline__ unsigned xb_xcc_id() { return (unsigned)__builtin_amdgcn_s_getreg((3 << 11) | 20) & 0xFu; }
#define XB_SPIN(cond, bar) do { unsigned _sp = 0; while (cond) { __builtin_amdgcn_s_sleep(1); \
    if ((++_sp & 255u) == 0u) { if (xb_ld(&(bar)[XB_TMO])) break; if (_sp > XB_SPIN_CAP) { atomicAdd(&(bar)[XB_TMO], 1u); break; } } } } while (0)
struct XcdBarrier { unsigned* bar; unsigned x; volatile LAS unsigned* st; };
__device__ __forceinline__ XcdBarrier xcd_barrier_post(unsigned* bar, volatile LAS unsigned* st) {
    XcdBarrier b; b.bar = bar; b.x = xb_xcc_id(); b.st = st;
    if (threadIdx.x == 0) (void)xb_add(&bar[XB_XCNT(b.x)], 1u);
    return b;
}
__device__ __forceinline__ void xcd_barrier_complete(unsigned* bar, unsigned x, unsigned& nloc, unsigned& nx) {
    const unsigned G = gridDim.x * gridDim.y * gridDim.z;
    unsigned sum, cnt, mine, sp = 0u;
    for (;;) {
        sum = 0u; cnt = 0u; mine = 0u;
#pragma unroll
        for (unsigned j = 0; j < 16; ++j) { const unsigned c = xb_ld(&bar[XB_XCNT(j)]); sum += c; cnt += (c > 0u) ? 1u : 0u; mine = (j == x) ? c : mine; }
        if (sum == G) break;
        __builtin_amdgcn_s_sleep(1);
        if ((++sp & 255u) == 0u) { if (xb_ld(&bar[XB_TMO])) break; if (sp > XB_SPIN_CAP) { atomicAdd(&bar[XB_TMO], 1u); break; } }
    }
    nloc = mine > 0u ? mine : 1u; nx = cnt > 0u ? cnt : 1u;
}
__device__ __forceinline__ void xcd_barrier_census(const XcdBarrier& b) {
    if (threadIdx.x == 0) { unsigned nloc, nx; xcd_barrier_complete(b.bar, b.x, nloc, nx); b.st[0] = nloc; b.st[1] = nx; }
    __syncthreads();
}
__device__ __forceinline__ void xcd_barrier(const XcdBarrier& b) {
    asm volatile("s_waitcnt vmcnt(0)" ::: "memory");
    __syncthreads();
    if (threadIdx.x == 0) {
        unsigned* bar = b.bar;
        __builtin_amdgcn_s_waitcnt(0);
        unsigned nloc = b.st[0], nx = b.st[1];
        if (nloc == 0u) { nloc = 1u; nx = 1u; }
        const unsigned old = xb_add(&bar[XB_XSUB(b.x)], 1u);
        const unsigned gen = old / nloc;
        if (old + 1u == (gen + 1u) * nloc) {
            __builtin_amdgcn_fence(__ATOMIC_RELEASE, "agent");
            asm volatile("s_waitcnt vmcnt(0)" ::: "memory");
            const unsigned og = xb_add(&bar[XB_TOP], 1u);
            const unsigned tg = og / nx;
            if (og + 1u == (tg + 1u) * nx) xb_add(&bar[XB_TOPGEN], 1u);
            else XB_SPIN(xb_ld(&bar[XB_TOPGEN]) == tg, bar);
            __builtin_amdgcn_fence(__ATOMIC_ACQUIRE, "agent");
            xb_add(&bar[XB_XGEN(b.x)], 1u);
            asm volatile("s_waitcnt vmcnt(0)" ::: "memory");
        } else {
            XB_SPIN(xb_ld(&bar[XB_XGEN(b.x)]) == gen, bar);
            __builtin_amdgcn_fence(__ATOMIC_ACQUIRE, "agent");
            asm volatile("s_waitcnt vmcnt(0)" ::: "memory");
        }
    }
    __syncthreads();
}

struct Args { const float* in[25]; float* out; unsigned char* ws; int ph_lo, ph_hi; };
enum { I_X = 0, I_C, I_CTX, I_CCTX, I_ADAW, I_ADAB, I_F1N, I_F1GU, I_F1D, I_MIXN, I_WIN, I_CONVW, I_QN, I_WQB, I_KVN, I_WKVB, I_SINK, I_WBC, I_WBM, I_WBG, I_WOUT, I_F2N, I_F2GU, I_F2D, I_FINN };

__device__ __forceinline__ int gqa_dim2phys(int d) { int i, n, p; if (d < 64) { i = d & 31; n = d >> 5; p = i; } else { i = (d - 64) & 31; n = (d - 64) >> 5; p = 32 + i; } const int wc = p >> 4, fq = (p >> 2) & 3, e = p & 3; return 32 * wc + 8 * fq + 4 * n + e; }
__device__ __forceinline__ int mla_dim2phys(int hh, int d) { int i, n, pp; if (d < 32) { i = d & 15; n = d >> 4; pp = i; } else { i = (d - 32) & 15; n = (d - 32) >> 4; pp = 16 + i; } const int p = 32 * hh + pp; const int wc = p >> 4, fq = (p >> 2) & 3, e = p & 3; return 32 * wc + 8 * fq + 4 * n + e; }
__device__ __forceinline__ int phys_row(int mode, int c) {
    if (mode == 0) return c;
    if (mode == 1) { return c < FF ? 256 * (c >> 7) + (c & 127) : 256 * ((c - FF) >> 7) + 128 + ((c - FF) & 127); }
    if (mode == 2) {
        if (c < OFF_GQA) return c;
        if (c < OFF_GATE) { const int j = c - OFF_GQA; if (j >= 1280) return 4096 + j; return 4096 + (j >> 7) * 128 + gqa_dim2phys(j & 127); }
        return 5632 + (c - OFF_GATE);
    }
    { const int h = c / 192, d = c - h * 192; if (d < 128) return h * 128 + d; return 1024 + (h >> 1) * 128 + mla_dim2phys(h & 1, d - 128); }
}
__device__ __forceinline__ void transpose_item(const float* __restrict__ W, int K, int N, bf16_t* __restrict__ WT, int mode, const float* __restrict__ kscale, LAS float* scr, int item, int lane) {
    const int nblk = N / 32, kb = item / nblk, nb = item - kb * nblk, k0 = 64 * kb, n0 = 32 * nb;
    float tv[32];
#pragma unroll
    for (int i = 0; i < 32; ++i) tv[i] = W[(size_t)(k0 + 2 * i + (lane >> 5)) * N + n0 + (lane & 31)];
#pragma unroll
    for (int i = 0; i < 32; ++i) { const int kk = 2 * i + (lane >> 5); float v = tv[i]; if (kscale) v *= kscale[k0 + kk]; scr[kk * 33 + (lane & 31)] = v; }
    LDS_WAIT(); asm volatile("" ::: "memory");
    const int c = lane & 7;
#pragma unroll
    for (int j = 0; j < 4; ++j) { const int n = (lane >> 3) + 8 * j; const LAS float* s = scr + (8 * c) * 33 + n;
        u32x4 o; o.x = pk2(s[0 * 33], s[1 * 33]); o.y = pk2(s[2 * 33], s[3 * 33]); o.z = pk2(s[4 * 33], s[5 * 33]); o.w = pk2(s[6 * 33], s[7 * 33]);
        *(u32x4*)(WT + (size_t)phys_row(mode, n0 + n) * K + k0 + 8 * c) = o; }
    LDS_WAIT(); asm volatile("" ::: "memory");
}


constexpr int PT_OFF = LDSCTL_OFF + 512;
__device__ __forceinline__ unsigned long long inaddr(unsigned pto, int k) {
    const unsigned long long v = *(const LAS unsigned long long*)(uintptr_t)(pto + 8u * (unsigned)k);
    const unsigned lo = __builtin_amdgcn_readfirstlane((unsigned)v), hi = __builtin_amdgcn_readfirstlane((unsigned)(v >> 32));
    return ((unsigned long long)hi << 32) | lo;
}
template <class T> __device__ __forceinline__ T* gptr(unsigned long long a) { return (T*)(GAS T*)a; }
__device__ __forceinline__ const float* inptr(unsigned pto, int k) { return gptr<const float>(inaddr(pto, k)); }
struct Frame {
    LAS unsigned char* lds; int tid, lane, wave, G, vcu;
};
__device__ __forceinline__ Frame fresh(const Frame& F0) { Frame F = F0; int t = threadIdx.x; asm volatile("" : "+v"(t)); F.tid = t; F.lane = t & 63; F.wave = __builtin_amdgcn_readfirstlane(t >> 6); return F; }

constexpr int CV_GU = (DM / 64) * (2 * FF / 32), CV_D = (FF / 64) * (DM / 32), CV_IN = (DM / 64) * (INC / 32), CV_QB = (512 / 64) * (1536 / 32), CV_KVB = (256 / 64) * (2048 / 32),
              CV_BR = (1024 / 64) * (DM / 32), CV_OUT = (DM / 64) * (DM / 32);
constexpr int CV_NITEMS = 2 * CV_GU + 2 * CV_D + CV_IN + CV_QB + CV_KVB + 3 * CV_BR + CV_OUT, CV_NTOT = CV_NITEMS + 192;
__device__ __forceinline__ void convert_item(unsigned pto, unsigned char* wsb, int l, LAS float* scr, int it, int lane) {
    if (it >= CV_NITEMS) {
        unsigned zz = 0u; asm volatile("" : "+v"(zz));
        u32x4* z = (u32x4*)(wsb + W_IN + (size_t)(OFF_MLA + 832 + (it - CV_NITEMS)) * DM * 2);
#pragma unroll
        for (int i = 0; i < 4; ++i) z[lane + 64 * i] = (u32x4){zz, zz, zz, zz};
        return;
    }
    int r = it, idx = I_F1GU, K = DM, N = 2 * FF, mode = 1, ksi = -1; size_t lstr = (size_t)DM * 2 * FF, woff = W_GU1; bool hit = false;
#define CV_CASE(cnt, idx_, lstr_, K_, N_, woff_, mode_, ksi_) if (!hit) { if (r < (cnt)) { hit = true; idx = (idx_); lstr = (lstr_); K = (K_); N = (N_); woff = (woff_); mode = (mode_); ksi = (ksi_); } else r -= (cnt); }
    CV_CASE(CV_GU, I_F1GU, (size_t)DM * 2 * FF, DM, 2 * FF, W_GU1, 1, -1)
    CV_CASE(CV_GU, I_F2GU, (size_t)DM * 2 * FF, DM, 2 * FF, W_GU2, 1, -1)
    CV_CASE(CV_D, I_F1D, (size_t)FF * DM, FF, DM, W_D1, 0, -1)
    CV_CASE(CV_D, I_F2D, (size_t)FF * DM, FF, DM, W_D2, 0, -1)
    CV_CASE(CV_IN, I_WIN, (size_t)DM * INC, DM, INC, W_IN, 2, -1)
    CV_CASE(CV_QB, I_WQB, (size_t)512 * 1536, 512, 1536, W_QB, 3, I_QN)
    CV_CASE(CV_KVB, I_WKVB, (size_t)256 * 2048, 256, 2048, W_KVB, 0, I_KVN)
    CV_CASE(CV_BR, I_WBC, (size_t)1024 * DM, 1024, DM, W_BR, 0, -1)
    CV_CASE(CV_BR, I_WBM, (size_t)1024 * DM, 1024, DM, W_BR + 4 * MiB, 0, -1)
    CV_CASE(CV_BR, I_WBG, (size_t)1024 * DM, 1024, DM, W_BR + 8 * MiB, 0, -1)
    CV_CASE(CV_OUT, I_WOUT, (size_t)DM * DM, DM, DM, W_OUT, 0, -1)
#undef CV_CASE
    const float* ks = ksi >= 0 ? inptr(pto, ksi) + l * K : nullptr;
    transpose_item(inptr(pto, idx) + (size_t)l * lstr, K, N, (bf16_t*)(wsb + woff), mode, ks, scr, r, lane);
}
__device__ __forceinline__ void convert_weights(const Frame& F0, unsigned pto, unsigned char* ws, int l) {
    const Frame F = fresh(F0);
    LAS float* scr = (LAS float*)(F.lds + F.wave * 16384);
    const int gw = F.vcu * NWAVES + F.wave, NGW = F.G * NWAVES;
    for (int it = gw; it < CV_NTOT; it += NGW) convert_item(pto, ws, l, scr, it, F.lane);
}
constexpr int CV_BATCH = 16;
__device__ __forceinline__ bool fill_step(volatile LAS unsigned* st, int wave, int lane, GAS unsigned* ctr, unsigned pto, unsigned char* ws, LAS float* scr) {
    unsigned cur = (unsigned)__builtin_amdgcn_readfirstlane((int)st[8 + 2 * wave]), end = (unsigned)__builtin_amdgcn_readfirstlane((int)st[9 + 2 * wave]);
    if (cur == end) {
        if ((unsigned)__builtin_amdgcn_readfirstlane((int)__hip_atomic_load(ctr, __ATOMIC_RELAXED, __HIP_MEMORY_SCOPE_AGENT)) * (unsigned)CV_BATCH >= (unsigned)CV_NTOT) return false;
        unsigned tk = 0u; if (lane == 0) tk = __hip_atomic_fetch_add(ctr, 1u, __ATOMIC_RELAXED, __HIP_MEMORY_SCOPE_AGENT);
        tk = (unsigned)__builtin_amdgcn_readfirstlane((int)tk);
        cur = tk * CV_BATCH; end = cur + CV_BATCH;
        if (cur >= (unsigned)CV_NTOT) return false;
        if (end > (unsigned)CV_NTOT) end = (unsigned)CV_NTOT;
    }
    convert_item(pto, ws + W2_SHIFT, 1, scr, (int)cur, lane);
    if (lane == 0) { st[8 + 2 * wave] = cur + 1u; st[9 + 2 * wave] = end; }
    return true;
}
__device__ __forceinline__ void convert_finish(const Frame& F0, unsigned pto, unsigned char* ws, GAS unsigned* ctr, volatile LAS unsigned* st) {
    const Frame F = fresh(F0);
    LAS float* scr = (LAS float*)(F.lds + F.wave * 16384);
    while (fill_step(st, F.wave, F.lane, ctr, pto, ws, scr)) {}
}


__device__ __forceinline__ void slack_fill(const Frame& F0, unsigned pto, unsigned char* ws, GAS unsigned* ctr, volatile LAS unsigned* st, int n) {
    const Frame F = fresh(F0);
    LAS float* scr = (LAS float*)(F.lds + F.wave * 16384);
    for (int k = 0; k < n; ++k) if (!fill_step(st, F.wave, F.lane, ctr, pto, ws, scr)) break;
}

__device__ __forceinline__ void mod_gemv(const Frame& F0, unsigned pto, unsigned char* ws) {
    const Frame F = fresh(F0);
    LAS float* sv = (LAS float*)F.lds;
    LAS float* red = (LAS float*)(F.lds + 40960);
    for (int i = F.tid; i < 5 * DM; i += NWAVES * 64) { const int r = i >> 11, k = i & 2047; const float x = r < 4 ? inptr(pto, I_C)[r * DM + k] : inptr(pto, I_CCTX)[k]; sv[i] = silu_f(x); }
    __syncthreads();
    float* MOD = (float*)(ws + WS_MOD);
    const int half = F.lane >> 5, cl = F.lane & 31;
    for (int unit = blockIdx.x; unit < 2 * 144; unit += F.G) {
        const int l = unit / 144, cb = unit - l * 144;
        const float* wp = inptr(pto, I_ADAW) + ((size_t)l * DM + F.wave * 256 + half) * MODW + cb * 128 + cl * 4;
        f32x4 acc[5];
#pragma unroll
        for (int r = 0; r < 5; ++r) acc[r] = (f32x4){0.f, 0.f, 0.f, 0.f};
#pragma unroll 8
        for (int it = 0; it < 128; ++it) { const f32x4 w = *(const f32x4*)(wp + (size_t)it * 2 * MODW); const int k = F.wave * 256 + it * 2 + half;
#pragma unroll
            for (int r = 0; r < 5; ++r) acc[r] += w * sv[r * DM + k]; }
#pragma unroll
        for (int r = 0; r < 5; ++r) *(LAS f32x4*)(red + ((F.wave * 2 + half) * 5 + r) * 128 + cl * 4) = acc[r];
        __syncthreads();
        for (int o = F.tid; o < 640; o += NWAVES * 64) { const int r = o >> 7, cc = o & 127; float s = 0.f;
#pragma unroll
            for (int p = 0; p < 16; ++p) s += red[(p * 5 + r) * 128 + cc];
            MOD[((size_t)l * 5 + r) * MODW + cb * 128 + cc] = s + inptr(pto, I_ADAB)[(size_t)l * MODW + cb * 128 + cc]; }
        __syncthreads();
    }
}
__device__ __forceinline__ void rope_tables(const Frame& F0, unsigned char* ws) {
    const Frame F = fresh(F0);
    if (blockIdx.x != 0) return;
    float* c64 = (float*)(ws + WS_ROPE); float* s64 = c64 + 2048; float* c32 = s64 + 2048; float* s32 = c32 + 1024;
    for (int i = F.tid; i < 2048; i += NWAVES * 64) { const int pos = i >> 5, f = i & 31; const float inv = __builtin_amdgcn_exp2f(-(float)f * (13.287712379549449f / 32.0f)); const float ang = (float)pos * inv;
        c64[i] = cosf(ang); s64[i] = sinf(ang); }
    for (int i = F.tid; i < 1024; i += NWAVES * 64) { const int pos = i >> 4, f = i & 15; const float inv = __builtin_amdgcn_exp2f(-(float)f * (13.287712379549449f / 16.0f)); const float ang = (float)pos * inv;
        c32[i] = cosf(ang); s32[i] = sinf(ang); }
}

__device__ __forceinline__ void norm_phase(const Frame& F0, const float* src_lat, const float* src_ctx, const float* gain, const float* modl, int ishift, int iscale, bf16_t* XN, int nrows,
                                           const float* part, const float* fgate, float fcoef, float* hctx_out) {
    const Frame F = fresh(F0);
    const int gw = F.vcu * NWAVES + F.wave, NGW = F.G * NWAVES;
    if (NGW % 4 == 0 && SEQ % (NGW / 4) == 0) {
        const int wpb = NGW / 4, b = gw / wpb, wi = gw - b * wpb, nI = SEQ / wpb;
        const float* sh = modl + (size_t)b * MODW + ishift * DM; const float* sc = modl + (size_t)b * MODW + iscale * DM;
        f32x4 gm[8], sv[8];
        { f32x4 g_[8], s_[8];
#pragma unroll
          for (int j = 0; j < 8; ++j) { const int c = 256 * j + 4 * F.lane; g_[j] = *(const f32x4*)(gain + c); s_[j] = *(const f32x4*)(sc + c); sv[j] = *(const f32x4*)(sh + c); }
          asm volatile("" ::: "memory");
#pragma unroll
          for (int j = 0; j < 8; ++j) gm[j] = g_[j] * (s_[j] + 1.0f); }
        const float* s0p = src_lat + ((size_t)b * SEQ + wi) * DM + 4 * F.lane; bf16_t* x0p = XN + ((size_t)b * SEQ + wi) * DM + 4 * F.lane;
#define NP_LOAD(V, i) do { const float* sp_ = s0p + (size_t)(i) * wpb * DM; _Pragma("unroll") for (int j = 0; j < 8; ++j) V[j] = *(const f32x4*)(sp_ + 256 * j); } while (0)
#define NP_PROC(V, i) do { float ss_ = 0.f; _Pragma("unroll") for (int j = 0; j < 8; ++j) ss_ += (V[j][0] * V[j][0] + V[j][1] * V[j][1]) + (V[j][2] * V[j][2] + V[j][3] * V[j][3]); \
        const float r_ = 1.0f / sqrtf(wave_sum(ss_, F.lane) * (1.0f / DM) + EPS); bf16_t* xp_ = x0p + (size_t)(i) * wpb * DM; \
        _Pragma("unroll") for (int j = 0; j < 8; ++j) { const f32x4 y = (V[j] * r_) * gm[j] + sv[j]; u32x2 w; w.x = pk2(y[0], y[1]); w.y = pk2(y[2], y[3]); *(u32x2*)(xp_ + 256 * j) = w; } } while (0)
        f32x4 vA[8], vB[8];
        NP_LOAD(vA, 0);
        for (int i = 0; i < nI; i += 2) {
            if (i + 1 < nI) NP_LOAD(vB, i + 1);
            NP_PROC(vA, i);
            if (i + 1 >= nI) break;
            if (i + 2 < nI) NP_LOAD(vA, i + 2);
            NP_PROC(vB, i + 1);
        }
#undef NP_LOAD
#undef NP_PROC
    } else {
        for (int row = gw; row < TL; row += NGW) {
            const float* src = src_lat + (size_t)row * DM; const int mrow = row >> 12;
            const float* sh = modl + (size_t)mrow * MODW + ishift * DM; const float* sc = modl + (size_t)mrow * MODW + iscale * DM;
            f32x4 v[8]; float ss = 0.f;
#pragma unroll
            for (int j = 0; j < 8; ++j) { v[j] = *(const f32x4*)(src + 256 * j + 4 * F.lane); ss += (v[j][0] * v[j][0] + v[j][1] * v[j][1]) + (v[j][2] * v[j][2] + v[j][3] * v[j][3]); }
            const float r = 1.0f / sqrtf(wave_sum(ss, F.lane) * (1.0f / DM) + EPS);
#pragma unroll
            for (int j = 0; j < 8; ++j) { const int c = 256 * j + 4 * F.lane; const f32x4 g = *(const f32x4*)(gain + c), s1 = *(const f32x4*)(sc + c), s0 = *(const f32x4*)(sh + c);
                const f32x4 y = (v[j] * r) * g * (s1 + 1.0f) + s0;
                u32x2 w; w.x = pk2(y[0], y[1]); w.y = pk2(y[2], y[3]); *(u32x2*)(XN + (size_t)row * DM + c) = w; }
        }
    }
    for (int row = TL + gw; row < nrows; row += NGW) {
        const float* src = src_ctx + (size_t)(row - TL) * DM + 4 * F.lane;
        const float* sh = modl + (size_t)4 * MODW + ishift * DM + 4 * F.lane; const float* sc = modl + (size_t)4 * MODW + iscale * DM + 4 * F.lane;
        f32x4 v[8]; float ss = 0.f;
        if (part != nullptr) {
            const float* pr = part + (size_t)(row - TL) * DM + 4 * F.lane; float* ho = hctx_out + (size_t)(row - TL) * DM + 4 * F.lane;
#pragma unroll
            for (int hf = 0; hf < 2; ++hf) {
                f32x4 s_[4], p0[4], p1[4], p2[4], p3[4], g_[4];
#pragma unroll
                for (int jj = 0; jj < 4; ++jj) { const int c = 256 * (hf * 4 + jj);
                    s_[jj] = *(const f32x4*)(src + c); p0[jj] = *(const f32x4*)(pr + c); p1[jj] = *(const f32x4*)(pr + (size_t)TC * DM + c);
                    p2[jj] = *(const f32x4*)(pr + (size_t)2 * TC * DM + c); p3[jj] = *(const f32x4*)(pr + (size_t)3 * TC * DM + c); g_[jj] = *(const f32x4*)(fgate + 4 * F.lane + c); }
                asm volatile("" ::: "memory");
#pragma unroll
                for (int jj = 0; jj < 4; ++jj) { const int j = hf * 4 + jj; const f32x4 p = (p0[jj] + p1[jj]) + (p2[jj] + p3[jj]);
                    v[j] = s_[jj] + (g_[jj] * fcoef) * p;
                    *(f32x4*)(ho + 256 * j) = v[j];
                    ss += (v[j][0] * v[j][0] + v[j][1] * v[j][1]) + (v[j][2] * v[j][2] + v[j][3] * v[j][3]); }
                asm volatile("" ::: "memory");
            }
        } else {
#pragma unroll
            for (int j = 0; j < 8; ++j) { v[j] = *(const f32x4*)(src + 256 * j); ss += (v[j][0] * v[j][0] + v[j][1] * v[j][1]) + (v[j][2] * v[j][2] + v[j][3] * v[j][3]); }
        }
        const float r = 1.0f / sqrtf(wave_sum(ss, F.lane) * (1.0f / DM) + EPS);
        f32x4 g[8], s1[8], s0[8];
#pragma unroll
        for (int j = 0; j < 8; ++j) { g[j] = *(const f32x4*)(gain + 4 * F.lane + 256 * j); s1[j] = *(const f32x4*)(sc + 256 * j); s0[j] = *(const f32x4*)(sh + 256 * j); }
        asm volatile("" ::: "memory");
#pragma unroll
        for (int j = 0; j < 8; ++j) { const f32x4 y = (v[j] * r) * g[j] * (s1[j] + 1.0f) + s0[j];
            u32x2 w; w.x = pk2(y[0], y[1]); w.y = pk2(y[2], y[3]); *(u32x2*)(XN + (size_t)row * DM + 4 * F.lane + 256 * j) = w; }
    }
}
__device__ __forceinline__ void final_norm(const Frame& F0, const float* H, const float* gain, float* out) {
    const Frame F = fresh(F0);
    const int gw = F.vcu * NWAVES + F.wave, NGW = F.G * NWAVES;
    f32x4 gv[8];
#pragma unroll
    for (int j = 0; j < 8; ++j) gv[j] = *(const f32x4*)(gain + 256 * j + 4 * F.lane);
    const int nI = (TL - gw + NGW - 1) / NGW;
    const float* s0p = H + (size_t)gw * DM + 4 * F.lane; float* o0p = out + (size_t)gw * DM + 4 * F.lane;
#define FN_LOAD(V, i) do { const float* sp_ = s0p + (size_t)(i) * NGW * DM; _Pragma("unroll") for (int j = 0; j < 8; ++j) V[j] = *(const f32x4*)(sp_ + 256 * j); } while (0)
#define FN_PROC(V, i) do { float ss_ = 0.f; _Pragma("unroll") for (int j = 0; j < 8; ++j) ss_ += (V[j][0] * V[j][0] + V[j][1] * V[j][1]) + (V[j][2] * V[j][2] + V[j][3] * V[j][3]); \
        const float r_ = 1.0f / sqrtf(wave_sum(ss_, F.lane) * (1.0f / DM) + EPS); float* op_ = o0p + (size_t)(i) * NGW * DM; \
        _Pragma("unroll") for (int j = 0; j < 8; ++j) *(f32x4*)(op_ + 256 * j) = (V[j] * r_) * gv[j]; } while (0)
    f32x4 vA[8], vB[8];
    if (nI > 0) {
        FN_LOAD(vA, 0);
        for (int i = 0; i < nI; i += 2) {
            if (i + 1 < nI) FN_LOAD(vB, i + 1);
            FN_PROC(vA, i);
            if (i + 1 >= nI) break;
            if (i + 2 < nI) FN_LOAD(vA, i + 2);
            FN_PROC(vB, i + 1);
        }
    }
#undef FN_LOAD
#undef FN_PROC
}
__device__ __forceinline__ void conv_phase(const Frame& F0, bf16_t* P, const float* cw, int nrows) {
    const Frame F = fresh(F0);
    const int gw = F.vcu * NWAVES + F.wave, NGW = F.G * NWAVES;
    if ((NGW & 1) != 0) return;
    const int ch0 = (gw & 1) * 512 + F.lane * 8;
    const f32x4 w0a = *(const f32x4*)(cw + ch0), w0b = *(const f32x4*)(cw + ch0 + 4), w1a = *(const f32x4*)(cw + 1024 + ch0), w1b = *(const f32x4*)(cw + 1024 + ch0 + 4),
                w2a = *(const f32x4*)(cw + 2048 + ch0), w2b = *(const f32x4*)(cw + 2048 + ch0 + 4);
    struct Item { u32x4 gb, gc0, v0, gcm, vm, gcp, vp; };
    const int nit = nrows * 2;
#define CV_LOADI(I, item) do { const int row_ = (item) >> 1; bool first_, last_; \
        if (row_ < TL) { const int t_ = row_ & (SEQ - 1); first_ = t_ == 0; last_ = t_ == SEQ - 1; } else { const int t_ = (row_ - TL) & (CTXL - 1); first_ = t_ == 0; last_ = t_ == CTXL - 1; } \
        const bf16_t* rp_ = P + (size_t)row_ * 3072 + ch0; I.gb = *(const u32x4*)rp_; I.gc0 = *(const u32x4*)(rp_ + 1024); I.v0 = *(const u32x4*)(rp_ + 2048); \
        I.gcm = (u32x4){0u, 0u, 0u, 0u}; I.vm = I.gcm; I.gcp = I.gcm; I.vp = I.gcm; \
        if (!first_) { I.gcm = *(const u32x4*)(rp_ - 3072 + 1024); I.vm = *(const u32x4*)(rp_ - 3072 + 2048); } \
        if (!last_) { I.gcp = *(const u32x4*)(rp_ + 3072 + 1024); I.vp = *(const u32x4*)(rp_ + 3072 + 2048); } } while (0)
#define CV_PROCI(I, item) do { u32x4 o_; _Pragma("unroll") for (int q = 0; q < 4; ++q) { \
            const float wl0 = q < 2 ? w0a[2 * q] : w0b[2 * q - 4], wh0 = q < 2 ? w0a[2 * q + 1] : w0b[2 * q - 3]; \
            const float wl1 = q < 2 ? w1a[2 * q] : w1b[2 * q - 4], wh1 = q < 2 ? w1a[2 * q + 1] : w1b[2 * q - 3]; \
            const float wl2 = q < 2 ? w2a[2 * q] : w2b[2 * q - 4], wh2 = q < 2 ? w2a[2 * q + 1] : w2b[2 * q - 3]; \
            const float lo_ = bflo(I.gb[q]) * (wl0 * bflo(I.gcm[q]) * bflo(I.vm[q]) + wl1 * bflo(I.gc0[q]) * bflo(I.v0[q]) + wl2 * bflo(I.gcp[q]) * bflo(I.vp[q])); \
            const float hi_ = bfhi(I.gb[q]) * (wh0 * bfhi(I.gcm[q]) * bfhi(I.vm[q]) + wh1 * bfhi(I.gc0[q]) * bfhi(I.v0[q]) + wh2 * bfhi(I.gcp[q]) * bfhi(I.vp[q])); \
            o_[q] = pk2(lo_, hi_); } \
        *(u32x4*)(P + (size_t)((item) >> 1) * 3072 + ch0) = o_; } while (0)
    Item A, B;
    int item = gw;
    if (item < nit) {
        CV_LOADI(A, item);
        for (;;) {
            const int itB = item + NGW; const bool hB = itB < nit;
            if (hB) CV_LOADI(B, itB);
            CV_PROCI(A, item);
            if (!hB) break;
            item = itB + NGW; const bool hA = item < nit;
            if (hA) CV_LOADI(A, item);
            CV_PROCI(B, itB);
            if (!hA) break;
        }
    }
#undef CV_LOADI
#undef CV_PROCI
}
__device__ __forceinline__ void krope_phase(const Frame& F0, const bf16_t* PMLA, bf16_t* KM, const float* cos32, const float* sin32) {
    const Frame F = fresh(F0);
    const int gw = F.vcu * NWAVES + F.wave, NGW = F.G * NWAVES; const int d = F.lane;
    for (int row0 = gw; row0 < TT; row0 += 4 * NGW) {
        float x[4];
#pragma unroll
        for (int k = 0; k < 4; ++k) { const int row = row0 + k * NGW; x[k] = bf2f(PMLA[(size_t)(row < TT ? row : TT - 1) * 1024 + 768 + d]); }
        asm volatile("" ::: "memory");
#pragma unroll
        for (int k = 0; k < 4; ++k) { const int row = row0 + k * NGW; if (row >= TT) break;
            const float y = shflx(x[k], 16, d);
            float o = x[k];
            if (row < TL) { const int t = row & (SEQ - 1); const int pos = d < 32 ? (t >> 6) : (t & 63); const float c = cos32[pos * 16 + (d & 15)], s = sin32[pos * 16 + (d & 15)];
                o = (d & 16) ? (y * s + x[k] * c) : (x[k] * c - y * s); }
            const bf16_t ob = (bf16_t)f2bf(o);
#pragma unroll
            for (int h = 0; h < 8; ++h) KM[(size_t)row * 1536 + h * 192 + 128 + d] = ob; }
    }
}

__global__ void __launch_bounds__(NWAVES * 64, 2) hybrid_fwd(Args args) {
    extern __shared__ __attribute__((aligned(16))) unsigned char lds_raw[];
    Frame F; F.lds = (LAS unsigned char*)lds_raw; F.tid = threadIdx.x; F.lane = F.tid & 63; F.wave = __builtin_amdgcn_readfirstlane(F.tid >> 6);
    F.G = gridDim.x; { const int bx = blockIdx.x; F.vcu = (F.G % 8 == 0) ? (bx % 8) * (F.G / 8) + bx / 8 : bx; }
    unsigned char* ws = args.ws;
    unsigned* ctl = (unsigned*)(ws + WS_CTL);
    volatile LAS unsigned* MISC = (volatile LAS unsigned*)(F.lds + MISC_OFF);
    for (int u = F.tid; u < (LDS_BYTES - LDSCTL_OFF) / 4; u += NWAVES * 64) ((LAS unsigned*)(F.lds + LDSCTL_OFF))[u] = 0u;
    __syncthreads();
    if (F.tid < 25) ((LAS unsigned long long*)(F.lds + PT_OFF))[F.tid] = (unsigned long long)args.in[F.tid];
    if (F.tid == 25) ((LAS unsigned long long*)(F.lds + PT_OFF))[25] = (unsigned long long)args.out;
    __syncthreads();
    const int lo = args.ph_lo, hi = args.ph_hi;
    const bool multi = (hi - lo) > 1;
    XcdBarrier bar; bar.bar = ctl + CW_BAR; bar.x = 0; bar.st = nullptr;
    if (multi) bar = xcd_barrier_post(ctl + CW_BAR, MISC + 8);
#ifndef PHT_MASK
#define PHT_MASK 0x7fff
#endif
#define PHT(j) ((PHT_MASK >> (j)) & 1)
#ifndef DUP_MASK
#define DUP_MASK 0
#endif
#define NREP(j) (((DUP_MASK >> (j)) & 1) ? 2 : 1)
#define IN(k) (lo <= (k) && (k) < hi)
#define SEAM(k) do { if (IN(k) && IN((k) + 1)) xcd_barrier(bar); } while (0)
#define PH_BEGIN GAS unsigned char* wsg = (GAS unsigned char*)ws; asm volatile("" : "+s"(wsg)); unsigned pto = PT_OFF; asm volatile("" : "+s"(pto)); const int bx = (int)blockIdx.x; (void)bx; (void)pto; unsigned char* wsp = (unsigned char*)wsg; (void)wsp;
#define WSP(T, off) ((T*)(GAS T*)(wsg + (off)))
#define MODL (WSP(const float, WS_MOD) + (size_t)l * 5 * MODW)
#define COS64 WSP(const float, WS_ROPE)
#define SIN64 (WSP(const float, WS_ROPE) + 2048)
#define COS32 (WSP(const float, WS_ROPE) + 4096)
#define SIN32 (WSP(const float, WS_ROPE) + 5120)
#define WL(off) ((off) + (l ? W2_SHIFT : (size_t)0))
#define FILLCTR ((GAS unsigned*)(wsg + WS_CTL) + CW_FILL)
#ifndef SLACK_GU
#define SLACK_GU 10
#endif
#ifndef SLACK_WIN
#define SLACK_WIN 12
#endif
#ifndef SLACK_MERGE
#define SLACK_MERGE 18
#endif
#define HLAT WSP(float, WS_H)
#define HCTX (WSP(float, WS_H) + (size_t)TL * DM)

    if (PHT(13) && IN(0)) { PH_BEGIN mod_gemv(F, pto, wsp); rope_tables(F, wsp); for (int rep = 0; rep < NREP(13); ++rep) convert_weights(F, pto, wsp, 0); }
    if (multi) xcd_barrier_census(bar);
    SEAM(0);

    for (int l = 0; l < 2; ++l) {
        const int pb = 1 + 13 * l;
        const int nM2 = l == 0 ? TT / 256 : TL / 256;

        if (PHT(0) && IN(pb + 0)) for (int rep = 0; rep < NREP(0); ++rep) { PH_BEGIN
            norm_phase(F, gptr<const float>(l == 0 ? inaddr(pto, I_X) : (unsigned long long)(wsg + WS_H)), gptr<const float>(l == 0 ? inaddr(pto, I_CTX) : (unsigned long long)(wsg + WS_H + (size_t)TL * DM * 4)), inptr(pto, I_F1N) + l * DM, MODL, 0, 1, WSP(bf16_t, WS_XN), TT,
                       gptr<const float>(l == 0 ? 0ull : (unsigned long long)(wsg + WS_PART)), WSP(const float, WS_MOD) + 4 * MODW + 8 * DM, 0.5f, HCTX); }
        SEAM(pb + 0);
        if (PHT(1) && IN(pb + 1)) for (int rep = 0; rep < NREP(1); ++rep) { PH_BEGIN
            pg8::Gemm g{WSP(bf16_t, WS_XN), WSP(const bf16_t, WL(W_GU1)), DM, DM, DM, 0, 0}; pg8::StaticOrder S; S.init(TT / 256, 2 * FF / 256, F.G, bx, DM);
            pg8::EpiSwiGLU E{WSP(bf16_t, WS_BIG)}; pg8::gemm_phase<pg8::EpiSwiGLU, pg8::StaticOrder, true>(F.lds, g, S, E);
            if (l == 0 && SLACK_GU > 0 && bx >= (TT / 256) * (2 * FF / 256) % F.G && (TT / 256) * (2 * FF / 256) % F.G != 0) slack_fill(F, pto, wsp, FILLCTR, MISC + 8, SLACK_GU); }
        SEAM(pb + 1);
        if (PHT(2) && IN(pb + 2)) { PH_BEGIN
            pg8::Gemm g{WSP(bf16_t, WS_BIG), WSP(const bf16_t, WL(W_D1)), FF, FF, FF, 0, 0}; pg8::SplitOrder S; S.init(64, DM / 256, F.G, bx, FF); S.ks = 4;
            pg8::EpiResid E{gptr<const float>(l == 0 ? inaddr(pto, I_X) : (unsigned long long)(wsg + WS_H)), nullptr, HLAT, MODL, 2, 0.5f, WSP(float, WS_PART)}; pg8::gemm_phase<pg8::EpiResid, pg8::SplitOrder, true>(F.lds, g, S, E); }
        SEAM(pb + 2);
        if (PHT(3) && IN(pb + 3)) { PH_BEGIN norm_phase(F, HLAT, gptr<const float>(l == 0 ? inaddr(pto, I_CTX) : (unsigned long long)(wsg + WS_H + (size_t)TL * DM * 4)), inptr(pto, I_MIXN) + l * DM, MODL, 3, 4, WSP(bf16_t, WS_XN), TT,
                       WSP(const float, WS_PART), MODL + 4 * MODW + 2 * DM, 0.5f, HCTX); }
        SEAM(pb + 3);
        if (PHT(4) && IN(pb + 4)) for (int rep = 0; rep < NREP(4); ++rep) { PH_BEGIN
            pg8::Gemm g{WSP(bf16_t, WS_XN), WSP(const bf16_t, WL(W_IN)), DM, DM, DM, 0, 0}; pg8::WinOrder S; S.init(l == 0 ? TT / 256 : TL / 256, INP / 256, F.G, bx, DM); S.trim = (l != 0);
            pg8::EpiWin E{WSP(bf16_t, WS_PCONV), WSP(bf16_t, WS_PMLA), WSP(bf16_t, WS_PGQA), WSP(bf16_t, WS_PGATE), WSP(float, WS_SSQ), COS64, SIN64};
            pg8::gemm_phase<pg8::EpiWin, pg8::WinOrder, true>(F.lds, g, S, E);
            if (l == 0 && SLACK_WIN > 0 && bx >= (TT / 256) * (INP / 256) % F.G && (TT / 256) * (INP / 256) % F.G != 0) slack_fill(F, pto, wsp, FILLCTR, MISC + 8, SLACK_WIN); }
        SEAM(pb + 4);
        if (PHT(5) && IN(pb + 5)) {
            { PH_BEGIN pg8::Gemm g{WSP(bf16_t, WS_PMLA), WSP(const bf16_t, WL(W_QB)), 1024, 512, 512, 0, 0}; pg8::StaticOrder S; S.init(nM2, 1536 / 256, F.G, bx, 512);
              pg8::EpiMlaQ E{WSP(bf16_t, WS_QMLA), WSP(const float, WS_SSQ), COS32, SIN32}; pg8::gemm_phase<pg8::EpiMlaQ, pg8::StaticOrder, true>(F.lds, g, S, E); }
            { PH_BEGIN pg8::Gemm g{WSP(bf16_t, WS_PMLA) + 512, WSP(const bf16_t, WL(W_KVB)), 1024, 256, 256, 0, 0}; pg8::StaticOrder S; S.init(TT / 256, 2048 / 256, F.G, (bx + F.G - (nM2 * (1536 / 256)) % F.G) % F.G, 256);
              pg8::EpiMlaKV E{WSP(bf16_t, WS_KMLA), WSP(bf16_t, WS_VMLA), WSP(const float, WS_SSQ)}; pg8::gemm_phase<pg8::EpiMlaKV, pg8::StaticOrder, true>(F.lds, g, S, E); }
            { PH_BEGIN krope_phase(F, WSP(const bf16_t, WS_PMLA), WSP(bf16_t, WS_KMLA), COS32, SIN32);
              conv_phase(F, WSP(bf16_t, WS_PCONV), inptr(pto, I_CONVW) + l * 3 * 1024, nM2 * 256); }
        }
        SEAM(pb + 5);
        if (PHT(6) && IN(pb + 6)) for (int rep = 0; rep < NREP(6); ++rep) { PH_BEGIN
            const int nU = l == 0 ? 1088 : 1024;
            bf16_t* QMLA = WSP(bf16_t, WS_QMLA); bf16_t* KMLA = WSP(bf16_t, WS_KMLA); bf16_t* VMLA = WSP(bf16_t, WS_VMLA); bf16_t* PGQA = WSP(bf16_t, WS_PGQA); bf16_t* PCONV = WSP(bf16_t, WS_PCONV);
            const float* sinkp = inptr(pto, I_SINK) + l * 8;
            for (int uix = F.vcu; uix < nU; uix += F.G) {
                if (uix < 512) {
                    const int bh = uix >> 4, qb = uix & 15, b = bh >> 3, h = bh & 7; const long q0 = (long)b * SEQ + qb * 256;
                    att::attn_unit<192, 1536, 1536, 1024, 3072, false, false>(QMLA + q0 * 1536 + h * 192, KMLA + h * 192, VMLA + h * 128, PCONV + q0 * 3072 + 1024 + h * 128,
                        b * SEQ, 64, TL + b * CTXL, 68, 0, 0, 0.f, (char*)lds_raw);
                } else if (uix < 1024) {
                    const int v = uix - 512, bh = v >> 4, qb = v & 15, b = bh >> 3, h = bh & 7, kvh = h >> 2; const long q0 = (long)b * SEQ + qb * 256;
                    const int i0 = qb * 256, klo = i0 >= 128 ? i0 - 128 : 0, khi = i0 + 384 <= SEQ ? i0 + 384 : SEQ;
                    att::attn_unit<128, 1536, 1536, 1536, 3072, true, true>(PGQA + q0 * 1536 + h * 128, PGQA + 1024 + kvh * 128, PGQA + 1280 + kvh * 128, PCONV + q0 * 3072 + 2048 + h * 128,
                        TL + b * CTXL, 4, b * SEQ + klo, 4 + (khi - klo) / 64, i0, klo, sinkp[h] * LOG2E, (char*)lds_raw);
                } else if (uix < 1056) {
                    const int v = uix - 1024, b = v >> 3, h = v & 7; const long q0 = TL + (long)b * CTXL;
                    att::attn_unit<192, 1536, 1536, 1024, 3072, false, false>(QMLA + q0 * 1536 + h * 192, KMLA + h * 192, VMLA + h * 128, PCONV + q0 * 3072 + 1024 + h * 128,
                        TL + b * CTXL, 4, 0, 4, 0, 0, 0.f, (char*)lds_raw);
                } else {
                    const int v = uix - 1056, b = v >> 3, h = v & 7, kvh = h >> 2; const long q0 = TL + (long)b * CTXL;
                    att::attn_unit<128, 1536, 1536, 1536, 3072, false, true>(PGQA + q0 * 1536 + h * 128, PGQA + 1024 + kvh * 128, PGQA + 1280 + kvh * 128, PCONV + q0 * 3072 + 2048 + h * 128,
                        TL + b * CTXL, 4, 0, 4, 0, 0, sinkp[h] * LOG2E, (char*)lds_raw);
                }
            }
        }
        SEAM(pb + 6);
        if (PHT(7) && IN(pb + 7)) for (int rep = 0; rep < NREP(7); ++rep) { PH_BEGIN
            pg8::Gemm g{WSP(bf16_t, WS_PCONV), WSP(const bf16_t, WL(W_BR)), 3072, 1024, 1024, 2048, 4 * MiB}; pg8::MergeOrder S; S.init(nM2, DM / 256, F.G, bx, 1024);
            pg8::EpiMerge E{WSP(const bf16_t, WS_PGATE), WSP(bf16_t, WS_XN)}; pg8::gemm_phase<pg8::EpiMerge, pg8::MergeOrder, true>(F.lds, g, S, E);
            if (l == 0 && SLACK_MERGE > 0 && bx >= (TT / 256) * (DM / 256) % F.G && (TT / 256) * (DM / 256) % F.G != 0) slack_fill(F, pto, wsp, FILLCTR, MISC + 8, SLACK_MERGE); }
        SEAM(pb + 7);
        if (PHT(8) && IN(pb + 8)) { PH_BEGIN
            pg8::Gemm g{WSP(bf16_t, WS_XN), WSP(const bf16_t, WL(W_OUT)), DM, DM, DM, 0, 0}; pg8::SplitOrder S; S.init(64, DM / 256, F.G, bx, DM); S.ks = l == 0 ? 4 : 0;
            pg8::EpiResid E{HLAT, nullptr, HLAT, MODL, 5, 1.0f, gptr<float>(l == 0 ? (unsigned long long)(wsg + WS_PART) : 0ull)}; pg8::gemm_phase<pg8::EpiResid, pg8::SplitOrder, true>(F.lds, g, S, E); }
        SEAM(pb + 8);
        if (PHT(9) && IN(pb + 9)) { PH_BEGIN norm_phase(F, HLAT, HCTX, inptr(pto, I_F2N) + l * DM, MODL, 6, 7, WSP(bf16_t, WS_XN), nM2 * 256,
                       gptr<const float>(l == 0 ? (unsigned long long)(wsg + WS_PART) : 0ull), MODL + 4 * MODW + 5 * DM, 1.0f, HCTX); }
        SEAM(pb + 9);
        if (PHT(10) && IN(pb + 10)) { PH_BEGIN
            pg8::Gemm g{WSP(bf16_t, WS_XN), WSP(const bf16_t, WL(W_GU2)), DM, DM, DM, 0, 0}; pg8::StaticOrder S; S.init(nM2, 2 * FF / 256, F.G, bx, DM);
            pg8::EpiSwiGLU E{WSP(bf16_t, WS_BIG)}; pg8::gemm_phase<pg8::EpiSwiGLU, pg8::StaticOrder, true>(F.lds, g, S, E);
            if (l == 0 && SLACK_GU > 0 && bx >= nM2 * (2 * FF / 256) % F.G && nM2 * (2 * FF / 256) % F.G != 0) slack_fill(F, pto, wsp, FILLCTR, MISC + 8, SLACK_GU); }
        SEAM(pb + 10);
        if (PHT(11) && IN(pb + 11)) { PH_BEGIN
            pg8::Gemm g{WSP(bf16_t, WS_BIG), WSP(const bf16_t, WL(W_D2)), FF, FF, FF, 0, 0}; pg8::SplitOrder S; S.init(64, DM / 256, F.G, bx, FF); S.ks = l == 0 ? 4 : 0;
            pg8::EpiResid E{HLAT, nullptr, HLAT, MODL, 8, 0.5f, gptr<float>(l == 0 ? (unsigned long long)(wsg + WS_PART) : 0ull)}; pg8::gemm_phase<pg8::EpiResid, pg8::SplitOrder, true>(F.lds, g, S, E); }
        if (l != 0) SEAM(pb + 11);
        if (PHT(12) && IN(pb + 12)) { if (l == 0) { PH_BEGIN convert_finish(F, pto, wsp, FILLCTR, MISC + 8); } }
        if (l == 0) SEAM(pb + 12);
    }
    if (PHT(14) && IN(27)) { PH_BEGIN final_norm(F, HLAT, inptr(pto, I_FINN), gptr<float>(inaddr(pto, 25))); }
#undef IN
#undef SEAM
}

constexpr int N_PHASES = 28;
extern "C" void kernel_launch(void* const* d_in, const int* in_sizes, int n_in, void* d_out, int out_size, void* d_ws, size_t ws_size, hipStream_t stream) {
    static int grid = 0;
    if (grid == 0) {
        if (n_in != 25 || in_sizes[0] != TL * DM || out_size != TL * DM || ws_size < WS_END) {
            fprintf(stderr, "kernel_launch: shape mismatch n_in %d in0 %d out %d ws %zu (need %zu)\n", n_in, n_in > 0 ? in_sizes[0] : -1, out_size, ws_size, (size_t)WS_END); grid = -1; return; }
        int dev = 0, cus = 0;
        if (hipGetDevice(&dev) != hipSuccess || hipDeviceGetAttribute(&cus, hipDeviceAttributeMultiprocessorCount, dev) != hipSuccess) { grid = -1; return; }
        if (hipFuncSetAttribute((const void*)hybrid_fwd, hipFuncAttributeMaxDynamicSharedMemorySize, LDS_BYTES) != hipSuccess) { fprintf(stderr, "kernel_launch: hipFuncSetAttribute failed\n"); grid = -1; return; }
        (void)hipGetLastError();
        grid = cus;
    }
    if (grid < 0) return;
    (void)hipMemsetAsync((char*)d_ws + WS_CTL, 0, CTL_ZERO_BYTES, stream);
    Args a{};
    for (int i = 0; i < 25; ++i) a.in[i] = (const float*)d_in[i];
    a.out = (float*)d_out; a.ws = (unsigned char*)d_ws;
#if MK_ONE_LAUNCH
    a.ph_lo = 0; a.ph_hi = N_PHASES;
    hipLaunchKernelGGL(hybrid_fwd, dim3(grid), dim3(NWAVES * 64), LDS_BYTES, stream, a);
#else
    for (int k = 0; k < N_PHASES; ++k) {
        if (k == 26) continue;
        a.ph_lo = k; a.ph_hi = k + 1;
        hipLaunchKernelGGL(hybrid_fwd, dim3(grid), dim3(NWAVES * 64), LDS_BYTES, stream, a);
    }
#endif
    const hipError_t le = hipPeekAtLastError();
    if (le != hipSuccess) fprintf(stderr, "kernel_launch: launch failed: %s\n", hipGetErrorName(le));
}
```
